# Optimizing an MI355X kernel written in HIP

```python
import math
import jax, jax.numpy as jnp
from jax import lax
import numpy as np

D_MODEL = 1024
BATCH = 16
SEQ = 2048
DEPTH = 4

N_META = 16
D_FF = 2816
REC_WIDTH = 512
REC_BLOCKS = 8
REC_BLOCK_DIM = REC_WIDTH // REC_BLOCKS
CONV_WIDTH = 4
LRU_C = 8.0
N_Q_HEADS = 8
N_KV_HEADS = 2
Q_PER_KV = N_Q_HEADS // N_KV_HEADS
HEAD_DIM = 64
ATTN_WIDTH = N_Q_HEADS * HEAD_DIM
KV_WIDTH = N_KV_HEADS * HEAD_DIM
WINDOW = 128
BLOCK = 128
ROPE_DIM = HEAD_DIM // 4
ROPE_THETA = 500000.0
D_IN = 2 * REC_WIDTH + ATTN_WIDTH + 2 * KV_WIDTH
D_MIX = REC_WIDTH + ATTN_WIDTH
DEEPNORM_ALPHA = (2.0 * DEPTH) ** 0.25
DEEPNORM_BETA = (8.0 * DEPTH) ** -0.25
LN_EPS = 1e-5
RMS_EPS = 1e-6
NEG_INF = -1e30

kernel_name = "hybrid_rglru_swa_sink_macaron_deepnorm"


def layer_norm(x, g, b):
    xf = x.astype(jnp.float32)
    mu = jnp.mean(xf, axis=-1, keepdims=True)
    var = jnp.mean(jnp.square(xf - mu), axis=-1, keepdims=True)
    return ((xf - mu) * lax.rsqrt(var + LN_EPS) * g.astype(jnp.float32) + b.astype(jnp.float32)).astype(x.dtype)


def rms_norm(x, g):
    xf = x.astype(jnp.float32)
    ms = jnp.mean(jnp.square(xf), axis=-1, keepdims=True)
    return (xf * lax.rsqrt(ms + RMS_EPS) * g.astype(jnp.float32)).astype(x.dtype)


def swiglu(x, w_gate, w_up, w_down):
    return (jax.nn.silu(x @ w_gate) * (x @ w_up)) @ w_down


def causal_depthwise_conv(x, w, b):
    L = x.shape[1]
    xp = jnp.pad(x, ((0, 0), (CONV_WIDTH - 1, 0), (0, 0)))
    y = b + xp[:, 0:L] * w[0]
    for k in range(1, CONV_WIDTH):
        y = y + xp[:, k:k + L] * w[k]
    return y


def rglru(x, wa, ba, wx, bx, lam):
    B, L, _ = x.shape
    xb = x.reshape(B, L, REC_BLOCKS, REC_BLOCK_DIM)
    r = jax.nn.sigmoid(jnp.einsum('blhi,hij->blhj', xb, wa).reshape(B, L, REC_WIDTH) + ba).astype(jnp.float32)
    i = jax.nn.sigmoid(jnp.einsum('blhi,hij->blhj', xb, wx).reshape(B, L, REC_WIDTH) + bx)
    log_a = -LRU_C * jax.nn.softplus(-lam.astype(jnp.float32)) * r
    a = jnp.exp(log_a)
    gated_x = jnp.sqrt(-jnp.expm1(2.0 * log_a)) * (i * x).astype(jnp.float32)

    def combine(c1, c2):
        a1, b1 = c1
        a2, b2 = c2
        return a1 * a2, a2 * b1 + b2

    _, h = lax.associative_scan(combine, (a, gated_x), axis=1)
    return h.astype(x.dtype)


def rope_tables(L):
    pos = jnp.arange(L, dtype=jnp.float32)
    inv_freq = ROPE_THETA ** (-jnp.arange(0, ROPE_DIM, 2, dtype=jnp.float32) / ROPE_DIM)
    ang = pos[:, None] * inv_freq[None, :]
    return jnp.cos(ang), jnp.sin(ang)


def apply_partial_rope(t, cos, sin):
    tf = t.astype(jnp.float32)
    x1 = tf[..., :ROPE_DIM // 2]
    x2 = tf[..., ROPE_DIM // 2:ROPE_DIM]
    c = cos[None, :, None, :]
    s = sin[None, :, None, :]
    out = jnp.concatenate([x1 * c - x2 * s, x2 * c + x1 * s, tf[..., ROPE_DIM:]], axis=-1)
    return out.astype(t.dtype)


def swa_sink_attention(q, k, v, sinks):
    B, L = q.shape[0], q.shape[1]
    pad = (-L) % BLOCK
    nb = (L + pad) // BLOCK
    padl = ((0, 0), (pad, 0), (0, 0), (0, 0))
    qb = jnp.pad(q, padl).reshape(B, nb, BLOCK, N_KV_HEADS, Q_PER_KV, HEAD_DIM)
    kb = jnp.pad(k, padl).reshape(B, nb, BLOCK, N_KV_HEADS, HEAD_DIM)
    vb = jnp.pad(v, padl).reshape(B, nb, BLOCK, N_KV_HEADS, HEAD_DIM)
    prev = ((0, 0), (1, 0), (0, 0), (0, 0), (0, 0))
    k_band = jnp.concatenate([jnp.pad(kb, prev)[:, :-1], kb], axis=2)
    v_band = jnp.concatenate([jnp.pad(vb, prev)[:, :-1], vb], axis=2)
    k_meta = k[:, :N_META]
    v_meta = v[:, :N_META]
    scale = HEAD_DIM ** -0.5
    s_band = jnp.einsum('bnqgrd,bnkgd->bngrqk', qb, k_band).astype(jnp.float32) * scale
    s_meta = jnp.einsum('bnqgrd,bmgd->bngrqm', qb, k_meta).astype(jnp.float32) * scale
    q_pos = jnp.arange(nb)[:, None] * BLOCK + jnp.arange(BLOCK)[None, :] - pad
    k_pos = (jnp.arange(nb)[:, None] - 1) * BLOCK + jnp.arange(2 * BLOCK)[None, :] - pad
    dist = q_pos[:, :, None] - k_pos[:, None, :]
    band_mask = (dist >= 0) & (dist < WINDOW) & (k_pos[:, None, :] >= N_META)
    meta_mask = jnp.arange(N_META)[None, None, :] <= q_pos[:, :, None]
    s_band = jnp.where(band_mask[None, :, None, None], s_band, NEG_INF)
    s_meta = jnp.where(meta_mask[None, :, None, None], s_meta, NEG_INF)
    sink = jnp.broadcast_to(sinks.astype(jnp.float32).reshape(1, 1, N_KV_HEADS, Q_PER_KV, 1, 1),
                            s_meta.shape[:-1] + (1,))
    probs = jax.nn.softmax(jnp.concatenate([sink, s_meta, s_band], axis=-1), axis=-1)
    p_meta = probs[..., 1:1 + N_META].astype(v.dtype)
    p_band = probs[..., 1 + N_META:].astype(v.dtype)
    o = (jnp.einsum('bngrqm,bmgd->bnqgrd', p_meta, v_meta)
         + jnp.einsum('bngrqk,bnkgd->bnqgrd', p_band, v_band))
    return o.reshape(B, nb * BLOCK, ATTN_WIDTH)[:, pad:]


def hybrid_mixer(h, w_in, conv_w, conv_b, ga_w, ga_b, gx_w, gx_b, lam, sinks, g_rec, g_attn, w_out, cos, sin):
    B, L, _ = h.shape
    proj = h @ w_in
    x_rec, gate, q, k, v = jnp.split(
        proj, [REC_WIDTH, 2 * REC_WIDTH, 2 * REC_WIDTH + ATTN_WIDTH, 2 * REC_WIDTH + ATTN_WIDTH + KV_WIDTH], axis=-1)
    x_rec = causal_depthwise_conv(x_rec, conv_w, conv_b)
    y_rec = rglru(x_rec, ga_w, ga_b, gx_w, gx_b, lam) * jax.nn.gelu(gate, approximate=True)
    q = apply_partial_rope(q.reshape(B, L, N_Q_HEADS, HEAD_DIM), cos, sin)
    k = apply_partial_rope(k.reshape(B, L, N_KV_HEADS, HEAD_DIM), cos, sin)
    v = v.reshape(B, L, N_KV_HEADS, HEAD_DIM)
    y_attn = swa_sink_attention(q, k, v, sinks)
    y = jnp.concatenate([rms_norm(y_rec, g_rec), rms_norm(y_attn, g_attn)], axis=-1)
    return y @ w_out


def setup_inputs(seed: int = 0) -> dict:
    key = jax.random.key(seed)
    ks = jax.random.split(key, 26)
    f32 = jnp.float32

    def nrm(k, shape, scale):
        return jax.random.normal(k, shape, f32) * scale

    u = jax.random.uniform(ks[12], (DEPTH, REC_WIDTH), f32, 0.9, 0.999)
    s = u ** (1.0 / LRU_C)
    lru_lambda = jnp.log(s) - jnp.log1p(-s)
    return {
        'x': nrm(ks[0], (BATCH, SEQ, D_MODEL), 1.0),
        'meta_tokens': nrm(ks[1], (N_META, D_MODEL), 1.0),
        'ffn1_w_gate': nrm(ks[2], (DEPTH, D_MODEL, D_FF), D_MODEL ** -0.5),
        'ffn1_w_up': nrm(ks[3], (DEPTH, D_MODEL, D_FF), D_MODEL ** -0.5),
        'ffn1_w_down': nrm(ks[4], (DEPTH, D_FF, D_MODEL), D_FF ** -0.5 * DEEPNORM_BETA),
        'ln1_g': 1.0 + nrm(ks[5], (DEPTH, D_MODEL), 0.02),
        'ln1_b': nrm(ks[6], (DEPTH, D_MODEL), 0.02),
        'w_in': nrm(ks[7], (DEPTH, D_MODEL, D_IN), D_MODEL ** -0.5),
        'conv_w': nrm(ks[8], (DEPTH, CONV_WIDTH, REC_WIDTH), CONV_WIDTH ** -0.5),
        'conv_b': nrm(ks[9], (DEPTH, REC_WIDTH), 0.02),
        'gate_a_w': nrm(ks[10], (DEPTH, REC_BLOCKS, REC_BLOCK_DIM, REC_BLOCK_DIM), REC_BLOCK_DIM ** -0.5),
        'gate_a_b': nrm(ks[11], (DEPTH, REC_WIDTH), 0.02),
        'gate_x_w': nrm(ks[13], (DEPTH, REC_BLOCKS, REC_BLOCK_DIM, REC_BLOCK_DIM), REC_BLOCK_DIM ** -0.5),
        'gate_x_b': nrm(ks[14], (DEPTH, REC_WIDTH), 0.02),
        'lru_lambda': lru_lambda,
        'attn_sinks': nrm(ks[15], (DEPTH, N_Q_HEADS), 0.5),
        'norm_rec_g': 1.0 + nrm(ks[16], (DEPTH, REC_WIDTH), 0.02),
        'norm_attn_g': 1.0 + nrm(ks[17], (DEPTH, ATTN_WIDTH), 0.02),
        'w_out': nrm(ks[18], (DEPTH, D_MIX, D_MODEL), D_MIX ** -0.5 * DEEPNORM_BETA),
        'ln2_g': 1.0 + nrm(ks[19], (DEPTH, D_MODEL), 0.02),
        'ln2_b': nrm(ks[20], (DEPTH, D_MODEL), 0.02),
        'ffn2_w_gate': nrm(ks[21], (DEPTH, D_MODEL, D_FF), D_MODEL ** -0.5),
        'ffn2_w_up': nrm(ks[22], (DEPTH, D_MODEL, D_FF), D_MODEL ** -0.5),
        'ffn2_w_down': nrm(ks[23], (DEPTH, D_FF, D_MODEL), D_FF ** -0.5 * DEEPNORM_BETA),
        'ln3_g': 1.0 + nrm(ks[24], (DEPTH, D_MODEL), 0.02),
        'ln3_b': nrm(ks[25], (DEPTH, D_MODEL), 0.02),
    }


def reference(x, meta_tokens, ffn1_w_gate, ffn1_w_up, ffn1_w_down, ln1_g, ln1_b, w_in, conv_w, conv_b,
              gate_a_w, gate_a_b, gate_x_w, gate_x_b, lru_lambda, attn_sinks, norm_rec_g, norm_attn_g,
              w_out, ln2_g, ln2_b, ffn2_w_gate, ffn2_w_up, ffn2_w_down, ln3_g, ln3_b):
    B = x.shape[0]
    meta = jnp.broadcast_to(meta_tokens[None].astype(x.dtype), (B, N_META, D_MODEL))
    h = jnp.concatenate([meta, x], axis=1)
    cos, sin = rope_tables(h.shape[1])
    for l in range(DEPTH):
        h = layer_norm(DEEPNORM_ALPHA * h + 0.5 * swiglu(h, ffn1_w_gate[l], ffn1_w_up[l], ffn1_w_down[l]),
                       ln1_g[l], ln1_b[l])
        m = hybrid_mixer(h, w_in[l], conv_w[l], conv_b[l], gate_a_w[l], gate_a_b[l], gate_x_w[l], gate_x_b[l],
                         lru_lambda[l], attn_sinks[l], norm_rec_g[l], norm_attn_g[l], w_out[l], cos, sin)
        h = layer_norm(DEEPNORM_ALPHA * h + m, ln2_g[l], ln2_b[l])
        h = layer_norm(DEEPNORM_ALPHA * h + 0.5 * swiglu(h, ffn2_w_gate[l], ffn2_w_up[l], ffn2_w_down[l]),
                       ln3_g[l], ln3_b[l])
    return h[:, N_META:]
```

```cpp
#include <hip/hip_runtime.h>
#include <hip/hip_cooperative_groups.h>
#include <cstdio>
#include <cstdint>
namespace cg = cooperative_groups;
namespace pg8 {
#define PG8_LAS __attribute__((address_space(3)))
typedef unsigned short bf16_t;
typedef short bf16x8 __attribute__((ext_vector_type(8)));
typedef float f32x4 __attribute__((ext_vector_type(4)));
typedef unsigned u32x4 __attribute__((ext_vector_type(4)));
constexpr int BM = 256, BK = 64, HALF = 128, HTB = HALF * BK * 2  , STAGE_BYTES = 8 * HTB, NXCD = 8, WGM = 8;

__host__ __device__ __forceinline__ int lds_byte(int r, int c) { const int st = (r >> 4) * 2 + (c >> 5), rr = r & 15, cc = c & 31, ob = rr * 64 + cc * 2; return st * 1024 + (ob ^ (((ob >> 9) & 1) << 5)); }
__host__ __device__ __forceinline__ void stage_rc(int b, int& R, int& C) { const int st = b / 1024, sb = b % 1024, swz = sb ^ (((sb >> 9) & 1) << 5); R = (st >> 1) * 16 + swz / 64; C = (st & 1) * 32 + (swz % 64) / 2; }
__host__ __device__ __forceinline__ int perm32(int rho) { const int n = rho >> 4, i = rho & 15; return 8 * (i >> 2) + 4 * n + (i & 3); }

struct Unit { int pm, pn; };
struct Gemm { const bf16_t* A; const bf16_t* Bt; int M, N, K; };

struct StaticOrder {
    int nM, nN, nwg, G, c;
    __host__ __device__ void init(int M, int N, int G_, int c_) { nM = M / BM; nN = N / BM; nwg = nM * nN; G = G_; c = c_; }
    __host__ __device__ bool next(int i, Unit& u) const {
        const long L = (long)i * G + c; if (L >= nwg) return false;
        int wgid = (int)L; { const int q = nwg / NXCD, r = nwg % NXCD, xcd = wgid % NXCD, off = wgid / NXCD; wgid = (xcd < r ? xcd * (q + 1) : r * (q + 1) + (xcd - r) * q) + off; }
        const int nig = WGM * nN, gid = wgid / nig, fm = gid * WGM, gsz = (nM - fm) < WGM ? (nM - fm) : WGM;
        u.pm = fm + ((wgid % nig) % gsz); u.pn = (wgid % nig) / gsz; return true;
    }
    __device__ __forceinline__ void a_ready(const Unit&) const {}
    __device__ __forceinline__ void done(const Unit&) const {}
};

__device__ __forceinline__ unsigned cvt_pk_bf16(float lo, float hi) { unsigned r; asm volatile("v_cvt_pk_bf16_f32 %0, %1, %2" : "=v"(r) : "v"(lo), "v"(hi)); return r; }
typedef float f32x2 __attribute__((ext_vector_type(2)));
template <class Epi, class Sched, bool ALIGN_EPI = false, bool SP2 = false>
__device__ __forceinline__ void gemm_phase(PG8_LAS unsigned char* lds, const Gemm g, const Sched& S, const Epi& E) {
    int tid_ = threadIdx.x; asm volatile("" : "+v"(tid_));
    const int tid = tid_, wid = __builtin_amdgcn_readfirstlane(tid >> 6), lane = tid & 63, wr = wid >> 2, wc = wid & 3, fr = lane & 15, fq = lane >> 4;
    const int K = g.K, nt = K / BK;
    unsigned voffA[2], voffB[2];
#pragma unroll
    for (int i = 0; i < 2; ++i) { int R, C; stage_rc(tid * 16 + i * 8192, R, C); const int Rb = Epi::PERM ? ((R & ~31) + perm32(R & 31)) : R;
        voffA[i] = (unsigned)(R * K + C) * 2u; voffB[i] = (unsigned)(Rb * K + C) * 2u; }
    const size_t kstep = (size_t)(BK * 2);
    const size_t hstep = (size_t)HALF * K * 2;
    const size_t tstep = 2 * hstep;
    const unsigned ldsw = (unsigned)wid * 1024u;
    const int aoff = lds_byte(wr * 64 + fr, fq * 8), boff = lds_byte(wc * 32 + fr, fq * 8);
#define PG8_SA(b, h) (((b) * 2 + (h)) * HTB)
#define PG8_SB(b, h) ((4 + (b) * 2 + (h)) * HTB)
#define PG8_STAGE(bufoff, gbase, voff) do { _Pragma("unroll") for (int _i = 0; _i < 2; ++_i) \
        __builtin_amdgcn_global_load_lds((const unsigned*)((const char*)(gbase) + (voff)[_i]), (PG8_LAS unsigned*)(lds + (bufoff) + ldsw + _i * 8192), 16, 0, 0); } while (0)
#define PG8_LDA(dst, b, h) do { _Pragma("unroll") for (int m = 0; m < 4; ++m) _Pragma("unroll") for (int k = 0; k < 2; ++k) dst[m][k] = *(const PG8_LAS bf16x8*)(lds + PG8_SA(b, h) + aoff + m * 2048 + k * 1024); } while (0)
#define PG8_LDB(dst, b, h) do { _Pragma("unroll") for (int n = 0; n < 2; ++n) _Pragma("unroll") for (int k = 0; k < 2; ++k) dst[n][k] = *(const PG8_LAS bf16x8*)(lds + PG8_SB(b, h) + boff + n * 2048 + k * 1024); } while (0)
#define PG8_MMA(ai, bj, At, Bt) do { __builtin_amdgcn_s_setprio(1); _Pragma("unroll") for (int m = 0; m < 4; ++m) _Pragma("unroll") for (int n = 0; n < 2; ++n) _Pragma("unroll") for (int k = 0; k < 2; ++k) \
        acc[ai][bj][m][n] = __builtin_amdgcn_mfma_f32_16x16x32_bf16(Bt[n][k], At[m][k], acc[ai][bj][m][n], 0, 0, 0); __builtin_amdgcn_s_setprio(0); } while (0)
#define PG8_WAIT_V(n) asm volatile("s_waitcnt vmcnt(" #n ")" ::: "memory")
#define PG8_WAIT_L(n) asm volatile("s_waitcnt lgkmcnt(" #n ")" ::: "memory")
#define PG8_BAR __builtin_amdgcn_s_barrier()
#define PG8_SCHED __builtin_amdgcn_sched_barrier(0)
    Unit cur, nxt; int ui = 0;
    if (!S.next(0, cur)) return;
    f32x4 acc[2][2][4][2];
#pragma unroll
    for (int a = 0; a < 2; ++a)
#pragma unroll
        for (int b = 0; b < 2; ++b)
#pragma unroll
            for (int m = 0; m < 4; ++m)
#pragma unroll
                for (int n = 0; n < 2; ++n) acc[a][b][m][n] = (f32x4){0.f, 0.f, 0.f, 0.f};
    bf16x8 At[4][2], B0[2][2], B1[2][2];
    const char* cA = (const char*)g.A + (size_t)cur.pm * tstep; const char* cB = (const char*)g.Bt + (size_t)cur.pn * tstep;
    S.a_ready(cur);
    if constexpr (SP2) {
        PG8_STAGE(PG8_SB(0, 0), cB, voffB); PG8_STAGE(PG8_SB(0, 1), cB + hstep, voffB); PG8_STAGE(PG8_SA(0, 0), cA, voffA); PG8_STAGE(PG8_SA(0, 1), cA + hstep, voffA);
        if (wr == 1) PG8_BAR;
        PG8_WAIT_V(2); PG8_BAR;
        PG8_STAGE(PG8_SB(1, 0), cB + kstep, voffB); PG8_STAGE(PG8_SA(1, 0), cA + kstep, voffA); PG8_STAGE(PG8_SB(1, 1), cB + hstep + kstep, voffB);
        PG8_WAIT_V(6); PG8_BAR;
    } else {
        PG8_STAGE(PG8_SB(0, 0), cB, voffB); PG8_STAGE(PG8_SA(0, 0), cA, voffA); PG8_STAGE(PG8_SB(0, 1), cB + hstep, voffB); PG8_STAGE(PG8_SA(0, 1), cA + hstep, voffA);
        if (wr == 1) PG8_BAR;
        PG8_WAIT_V(4); PG8_BAR;
        PG8_STAGE(PG8_SB(1, 0), cB + kstep, voffB); PG8_STAGE(PG8_SA(1, 0), cA + kstep, voffA); PG8_STAGE(PG8_SB(1, 1), cB + hstep + kstep, voffB);
        PG8_WAIT_V(6); PG8_BAR;
    }
    for (;;) {
        const bool has_next = S.next(ui + 1, nxt);
        const char* nA = has_next ? (const char*)g.A + (size_t)nxt.pm * tstep : cA; const char* nB = has_next ? (const char*)g.Bt + (size_t)nxt.pn * tstep : cB;
        for (int t = 0; t < nt; t += 2) {
            const bool last = (t == nt - 2);
            if constexpr (Epi::MID) { if (t == (nt >> 1)) E.mid(acc, cur, wr, wc, fr, fq); }
            const char* a1 = cA + (size_t)(t + 1) * kstep;
            const char* a2 = last ? nA : cA + (size_t)(t + 2) * kstep; const char* b2 = last ? nB : cB + (size_t)(t + 2) * kstep;
            const char* a3 = a2 + kstep; const char* b3 = b2 + kstep;
            if (last && has_next) S.a_ready(nxt);
            if constexpr (SP2) {
            PG8_LDB(B0, 0, 0); PG8_LDB(B1, 0, 1); PG8_SCHED; PG8_LDA(At, 0, 0); PG8_STAGE(PG8_SA(1, 1), a1 + hstep, voffA);
            PG8_WAIT_V(8); PG8_WAIT_L(0); PG8_BAR; PG8_MMA(0, 0, At, B0); PG8_MMA(0, 1, At, B1); PG8_BAR; PG8_SCHED;
            PG8_LDA(At, 0, 1); PG8_STAGE(PG8_SB(0, 0), b2, voffB); PG8_STAGE(PG8_SB(0, 1), b2 + hstep, voffB); PG8_STAGE(PG8_SA(0, 0), a2, voffA);
            PG8_WAIT_V(8); PG8_WAIT_L(0); PG8_BAR; PG8_MMA(1, 0, At, B0); PG8_MMA(1, 1, At, B1); PG8_BAR; PG8_SCHED;
            PG8_LDB(B0, 1, 0); PG8_LDB(B1, 1, 1); PG8_SCHED; PG8_LDA(At, 1, 0); PG8_STAGE(PG8_SA(0, 1), a2 + hstep, voffA);
            PG8_WAIT_V(8); PG8_WAIT_L(0); PG8_BAR; PG8_MMA(0, 0, At, B0); PG8_MMA(0, 1, At, B1); PG8_BAR; PG8_SCHED;
            PG8_LDA(At, 1, 1); PG8_STAGE(PG8_SB(1, 0), b3, voffB); PG8_STAGE(PG8_SB(1, 1), b3 + hstep, voffB); PG8_STAGE(PG8_SA(1, 0), a3, voffA);
            PG8_WAIT_V(8); PG8_WAIT_L(0); PG8_BAR; PG8_MMA(1, 0, At, B0); PG8_MMA(1, 1, At, B1); PG8_BAR; PG8_SCHED;
            } else {
            PG8_LDB(B0, 0, 0); PG8_SCHED; PG8_LDA(At, 0, 0); PG8_STAGE(PG8_SA(1, 1), a1 + hstep, voffA);
            PG8_WAIT_L(8); PG8_BAR; PG8_WAIT_L(0); PG8_MMA(0, 0, At, B0); PG8_BAR; PG8_SCHED;
            PG8_LDB(B1, 0, 1); PG8_STAGE(PG8_SB(0, 0), b2, voffB);
            PG8_BAR; PG8_WAIT_L(0); PG8_MMA(0, 1, At, B1); PG8_BAR;
            PG8_LDA(At, 0, 1); PG8_STAGE(PG8_SA(0, 0), a2, voffA);
            PG8_BAR; PG8_WAIT_L(0); PG8_MMA(1, 0, At, B0); PG8_BAR; PG8_SCHED;
            PG8_STAGE(PG8_SB(0, 1), b2 + hstep, voffB);
            PG8_WAIT_V(6); PG8_BAR; PG8_MMA(1, 1, At, B1); PG8_BAR;
            PG8_LDB(B0, 1, 0); PG8_SCHED; PG8_LDA(At, 1, 0); PG8_STAGE(PG8_SA(0, 1), a2 + hstep, voffA);
            PG8_WAIT_L(8); PG8_BAR; PG8_WAIT_L(0); PG8_MMA(0, 0, At, B0); PG8_BAR; PG8_SCHED;
            PG8_LDB(B1, 1, 1); PG8_STAGE(PG8_SB(1, 0), b3, voffB);
            PG8_BAR; PG8_WAIT_L(0); PG8_MMA(0, 1, At, B1); PG8_BAR;
            PG8_LDA(At, 1, 1); PG8_STAGE(PG8_SA(1, 0), a3, voffA);
            PG8_BAR; PG8_WAIT_L(0); PG8_MMA(1, 0, At, B0); PG8_BAR; PG8_SCHED;
            PG8_STAGE(PG8_SB(1, 1), b3 + hstep, voffB);
            PG8_WAIT_V(6); PG8_BAR; PG8_MMA(1, 1, At, B1); PG8_BAR;
            }
        }
        if constexpr (ALIGN_EPI) { if (wr == 0) PG8_BAR; }
        if constexpr (!Epi::AFTER_DRAIN) { E(acc, cur, wr, wc, fr, fq); S.done(cur); }
        if (!has_next) break;
#pragma unroll
        for (int a = 0; a < 2; ++a)
#pragma unroll
            for (int b = 0; b < 2; ++b)
#pragma unroll
                for (int m = 0; m < 4; ++m)
#pragma unroll
                    for (int n = 0; n < 2; ++n) acc[a][b][m][n] = (f32x4){0.f, 0.f, 0.f, 0.f};
        cur = nxt; cA = nA; cB = nB; ++ui;
        if constexpr (ALIGN_EPI) { if (wr == 1) PG8_BAR; }
    }
    PG8_WAIT_V(0);
    if constexpr (!ALIGN_EPI) { if (wr == 0) PG8_BAR; }
    PG8_BAR;
    if constexpr (Epi::AFTER_DRAIN) { E.fused(acc, cur, wr, wc, fr, fq, lds, wid, lane); S.done(cur); }
#undef PG8_SA
#undef PG8_SB
#undef PG8_STAGE
#undef PG8_LDA
#undef PG8_LDB
#undef PG8_MMA
#undef PG8_WAIT_V
#undef PG8_WAIT_L
#undef PG8_BAR
#undef PG8_SCHED
}

typedef unsigned u32x2 __attribute__((ext_vector_type(2)));
__device__ __forceinline__ float silu_f(float x) { return x * __builtin_amdgcn_rcpf(1.0f + __builtin_amdgcn_exp2f(-1.4426950408889634f * x)); }

struct EpiStore {
    static constexpr bool PERM = true, AFTER_DRAIN = false, MID = false;
    bf16_t* O; int ldc;
    __device__ __forceinline__ void mid(f32x4 (&)[2][2][4][2], const Unit&, int, int, int, int) const {}
    __device__ __forceinline__ void operator()(const f32x4 (&acc)[2][2][4][2], const Unit& u, int wr, int wc, int fr, int fq) const {
        const int row0 = u.pm * BM + wr * 64 + fr, col0 = u.pn * BM + wc * 32 + 8 * fq;
#pragma unroll
        for (int ai = 0; ai < 2; ++ai)
#pragma unroll
            for (int m = 0; m < 4; ++m) { bf16_t* rowp = O + (size_t)(row0 + ai * HALF + m * 16) * ldc + col0;
#pragma unroll
                for (int bj = 0; bj < 2; ++bj) { const f32x4 v0 = acc[ai][bj][m][0], v1 = acc[ai][bj][m][1];
                    u32x4 w; w.x = cvt_pk_bf16(v0[0], v0[1]); w.y = cvt_pk_bf16(v0[2], v0[3]); w.z = cvt_pk_bf16(v1[0], v1[1]); w.w = cvt_pk_bf16(v1[2], v1[3]);
                    *(u32x4*)(rowp + bj * HALF) = w; } }
    }
};
struct EpiSwiGLU {
    static constexpr bool PERM = true, AFTER_DRAIN = false, MID = false;
    bf16_t* O; int ldc;
    __device__ __forceinline__ void mid(f32x4 (&)[2][2][4][2], const Unit&, int, int, int, int) const {}
    __device__ __forceinline__ void operator()(const f32x4 (&acc)[2][2][4][2], const Unit& u, int wr, int wc, int fr, int fq) const {
        const int row0 = u.pm * BM + wr * 64 + fr, col0 = u.pn * HALF + wc * 32 + 8 * fq;
#pragma unroll
        for (int ai = 0; ai < 2; ++ai)
#pragma unroll
            for (int m = 0; m < 4; ++m) { bf16_t* rowp = O + (size_t)(row0 + ai * HALF + m * 16) * ldc + col0;
                const f32x4 g0 = acc[ai][0][m][0], g1 = acc[ai][0][m][1], u0 = acc[ai][1][m][0], u1 = acc[ai][1][m][1];
                u32x4 w;
                w.x = cvt_pk_bf16(silu_f(g0[0]) * u0[0], silu_f(g0[1]) * u0[1]); w.y = cvt_pk_bf16(silu_f(g0[2]) * u0[2], silu_f(g0[3]) * u0[3]);
                w.z = cvt_pk_bf16(silu_f(g1[0]) * u1[0], silu_f(g1[1]) * u1[1]); w.w = cvt_pk_bf16(silu_f(g1[2]) * u1[2], silu_f(g1[3]) * u1[3]);
                *(u32x4*)rowp = w; }
    }
};
template <bool STATS> struct EpiRes {
    static constexpr bool PERM = false, AFTER_DRAIN = false, MID = STATS;
    float* H; int ldc; float alpha, sc; const float* stats;
    __device__ __forceinline__ float rs(float ss) const { return __builtin_amdgcn_rsqf(ss * (1.0f / 512.0f) + 1e-6f); }
    __device__ __forceinline__ void mid(f32x4 (&acc)[2][2][4][2], const Unit& u, int wr, int wc, int fr, int fq) const {
        if constexpr (STATS) {
#pragma unroll
            for (int ai = 0; ai < 2; ++ai)
#pragma unroll
                for (int m = 0; m < 4; ++m) { const int r = u.pm * BM + ai * HALF + wr * 64 + m * 16 + fr;
                    const f32x2 st = *(const f32x2*)(stats + 2 * (size_t)r); const float s = rs(st.x) / rs(st.y);
#pragma unroll
                    for (int bj = 0; bj < 2; ++bj)
#pragma unroll
                        for (int n = 0; n < 2; ++n) acc[ai][bj][m][n] *= s;
                    asm volatile("" ::: "memory"); }
        }
    }
    __device__ __forceinline__ void operator()(const f32x4 (&acc)[2][2][4][2], const Unit& u, int wr, int wc, int fr, int fq) const {
        const int col0 = u.pn * BM + wc * 32 + 4 * fq;
#pragma unroll
        for (int ai = 0; ai < 2; ++ai)
#pragma unroll
            for (int m = 0; m < 4; ++m) { const int r = u.pm * BM + ai * HALF + wr * 64 + m * 16 + fr; float s = sc;
                if constexpr (STATS) { s = rs(stats[2 * (size_t)r + 1]); }
                float* rowp = H + (size_t)r * ldc + col0;
#pragma unroll
                for (int bj = 0; bj < 2; ++bj)
#pragma unroll
                    for (int n = 0; n < 2; ++n) { f32x4* p = (f32x4*)(rowp + bj * HALF + n * 16); const f32x4 h = *p; *p = h * alpha + acc[ai][bj][m][n] * s; } }
    }
};
}

constexpr int NWAVES = 8;
constexpr int BATCH = 16, SEQ = 2048, NMETA = 16, LTOK = SEQ + NMETA, DM = 1024, DFF = 2816, DIN = 1792, DEPTH = 4;
constexpr int MT = BATCH * LTOK;
constexpr float DN_ALPHA = 1.6817928305074290f;
constexpr float LN_EPS = 1e-5f;
#ifndef MK_LAUNCH_PER_PHASE
#define MK_LAUNCH_PER_PHASE 0
#endif
constexpr size_t MiB = 1u << 20;
constexpr size_t WS_CTL = 0, CTL_BYTES = 2 * MiB;
constexpr size_t WS_STATS = 65536;
constexpr size_t WS_ROPE = 2 * MiB;
constexpr size_t WS_W = 3 * MiB;
constexpr size_t W_GU = (size_t)2 * DFF * DM, W_D = (size_t)DM * DFF, W_IN = (size_t)DIN * DM, W_OUT = (size_t)DM * DM;
constexpr size_t W_LAYER = 2 * W_GU + 2 * W_D + W_IN + W_OUT;
constexpr size_t OFF_GU1 = 0, OFF_D1 = W_GU, OFF_IN = OFF_D1 + W_D, OFF_OUT = OFF_IN + W_IN, OFF_GU2 = OFF_OUT + W_OUT, OFF_D2 = OFF_GU2 + W_GU;
constexpr size_t WS_HF = WS_W + W_LAYER * 2 * DEPTH;
constexpr size_t WS_ACT = WS_HF + (size_t)MT * DM * 4;
constexpr size_t WS_PROJ = WS_ACT, WS_YMIX = WS_ACT + (size_t)MT * DIN * 2;
constexpr size_t WS_END = WS_ACT + (size_t)MT * DFF * 2;
static_assert(WS_YMIX + (size_t)MT * DM * 2 <= WS_END, "ws map");
static_assert(WS_STATS + (size_t)DEPTH * MT * 2 * 4 <= CTL_BYTES, "stats in ctl");
static_assert(WS_HF % 256 == 0 && WS_ACT % 256 == 0 && WS_YMIX % 256 == 0, "align");
constexpr int LDS_BYTES = 147456;

#define GAS __attribute__((address_space(1)))
#define LAS __attribute__((address_space(3)))
typedef unsigned short bf16;
typedef unsigned v4u __attribute__((ext_vector_type(4)));
typedef unsigned v2u __attribute__((ext_vector_type(2)));
typedef float f32x4 __attribute__((ext_vector_type(4)));
typedef float f32x16 __attribute__((ext_vector_type(16)));
typedef short bf16x8 __attribute__((ext_vector_type(8)));
#define LDS_WAIT() asm volatile("s_waitcnt lgkmcnt(0)" ::: "memory")
__device__ __forceinline__ unsigned pk2(float lo, float hi) { return pg8::cvt_pk_bf16(lo, hi); }
__device__ __forceinline__ float bflo(unsigned w) { return __uint_as_float(w << 16); }
__device__ __forceinline__ float bfhi(unsigned w) { return __uint_as_float(w & 0xffff0000u); }
__device__ __forceinline__ float wave_sum(float v) {
#pragma unroll
    for (int o = 1; o < 64; o <<= 1) v += __shfl_xor(v, o);
    return v;
}
__device__ __forceinline__ int crow(int r, int hi) { return (r & 3) + 8 * (r >> 2) + 4 * hi; }
__device__ __forceinline__ int row_of(int b, int t) { return b * LTOK + t; }

struct Args { const float* in[26]; float* out; unsigned char* ws; int ph_lo, ph_hi; };

__device__ __forceinline__ void transpose_item(const float* W, int K, int N, bf16* WT, int blk, int row_off, LAS float* scr, int item, int lane) {
    const int nblk = N / 32, kb = item / nblk, nb = item % nblk, k0 = 64 * kb, n0 = 32 * nb;
#pragma unroll 8
    for (int i = 0; i < 32; ++i) { const int kk = 2 * i + (lane >> 5); scr[kk * 33 + (lane & 31)] = W[(size_t)(k0 + kk) * N + n0 + (lane & 31)]; }
    LDS_WAIT();
    const int c = lane & 7;
#pragma unroll
    for (int j = 0; j < 4; ++j) { const int n = (lane >> 3) + 8 * j; const LAS float* s = scr + (8 * c) * 33 + n;
        v4u o; o.x = pk2(s[0 * 33], s[1 * 33]); o.y = pk2(s[2 * 33], s[3 * 33]); o.z = pk2(s[4 * 33], s[5 * 33]); o.w = pk2(s[6 * 33], s[7 * 33]);
        const int nn = n0 + n; const int drow = row_off + (nn >> 7) * blk + (nn & 127);
        *(v4u*)(WT + (size_t)drow * K + k0 + 8 * c) = o; }
    LDS_WAIT();
}
__device__ __forceinline__ void prologue(const Args& a, LAS unsigned char* lds, bf16* HB, int gw, int NGW, int wave, int lane) {
    LAS float* scr = (LAS float*)(lds + wave * 16384);
    constexpr int I_G = (DM / 64) * (DFF / 32), I_D = (DFF / 64) * (DM / 32), I_IN = (DM / 64) * (DIN / 32), I_OUT = (DM / 64) * (DM / 32);
    constexpr int I_LAYER = 4 * I_G + 2 * I_D + I_IN + I_OUT;
    bf16* Wb = (bf16*)(a.ws + WS_W);
    for (int it = gw; it < I_LAYER * DEPTH; it += NGW) {
        const int l = it / I_LAYER; int r = it % I_LAYER; bf16* Wl = Wb + (size_t)l * W_LAYER;
        if (r < I_G) { transpose_item(a.in[2] + (size_t)l * DM * DFF, DM, DFF, Wl + OFF_GU1, 256, 0, scr, r, lane); continue; } r -= I_G;
        if (r < I_G) { transpose_item(a.in[3] + (size_t)l * DM * DFF, DM, DFF, Wl + OFF_GU1, 256, 128, scr, r, lane); continue; } r -= I_G;
        if (r < I_D) { transpose_item(a.in[4] + (size_t)l * DM * DFF, DFF, DM, Wl + OFF_D1, 128, 0, scr, r, lane); continue; } r -= I_D;
        if (r < I_IN) { transpose_item(a.in[7] + (size_t)l * DM * DIN, DM, DIN, Wl + OFF_IN, 128, 0, scr, r, lane); continue; } r -= I_IN;
        if (r < I_OUT) { transpose_item(a.in[18] + (size_t)l * DM * DM, DM, DM, Wl + OFF_OUT, 128, 0, scr, r, lane); continue; } r -= I_OUT;
        if (r < I_G) { transpose_item(a.in[21] + (size_t)l * DM * DFF, DM, DFF, Wl + OFF_GU2, 256, 0, scr, r, lane); continue; } r -= I_G;
        if (r < I_G) { transpose_item(a.in[22] + (size_t)l * DM * DFF, DM, DFF, Wl + OFF_GU2, 256, 128, scr, r, lane); continue; } r -= I_G;
        transpose_item(a.in[23] + (size_t)l * DM * DFF, DFF, DM, Wl + OFF_D2, 128, 0, scr, r, lane);
    }
    float* HF = (float*)(a.ws + WS_HF);
    for (int r = gw; r < MT; r += NGW) {
        const int b = r / LTOK, t = r % LTOK;
        const float* src = t < NMETA ? a.in[1] + (size_t)t * DM : a.in[0] + ((size_t)b * SEQ + (t - NMETA)) * DM;
        const f32x4* s4 = (const f32x4*)src + lane; f32x4* d4 = (f32x4*)(HF + (size_t)r * DM) + lane; v2u* b2 = (v2u*)(HB + (size_t)r * DM) + lane;
#pragma unroll
        for (int j = 0; j < 4; ++j) { const f32x4 v = s4[64 * j]; d4[64 * j] = v; v2u o; o.x = pk2(v.x, v.y); o.y = pk2(v.z, v.w); b2[64 * j] = o; }
    }
    float* rope = (float*)(a.ws + WS_ROPE);
    for (int i = gw * 64 + lane; i < LTOK * 8; i += NGW * 64) {
        const int pos = i >> 3, f = i & 7;
        const float inv = __builtin_amdgcn_exp2f(-(float)f * (18.931568569324174f / 8.0f));
        const float ang = (float)pos * inv;
        const double rev = (double)ang * 0.15915494309189535; const float fr = (float)(rev - rint(rev));
        rope[pos * 16 + f] = __builtin_amdgcn_cosf(fr); rope[pos * 16 + 8 + f] = __builtin_amdgcn_sinf(fr);
    }
}

__device__ __forceinline__ void ln_rows(const float* gam, const float* bet, float* HF, bf16* HB, float* out, bool fin, int gw, int NGW, int lane) {
    f32x4 g4[4], b4[4];
#pragma unroll
    for (int j = 0; j < 4; ++j) { g4[j] = ((const f32x4*)gam)[lane + 64 * j]; b4[j] = ((const f32x4*)bet)[lane + 64 * j]; }
    for (int r = gw; r < MT; r += NGW) {
        f32x4* p = (f32x4*)(HF + (size_t)r * DM) + lane;
        f32x4 v[4]; float s = 0.f;
#pragma unroll
        for (int j = 0; j < 4; ++j) { v[j] = p[64 * j]; s += (v[j].x + v[j].y) + (v[j].z + v[j].w); }
        const float mean = wave_sum(s) * (1.f / DM); float s2 = 0.f;
#pragma unroll
        for (int j = 0; j < 4; ++j) { v[j] = v[j] - mean; s2 += (v[j].x * v[j].x + v[j].y * v[j].y) + (v[j].z * v[j].z + v[j].w * v[j].w); }
        const float rstd = 1.f / sqrtf(wave_sum(s2) * (1.f / DM) + LN_EPS);
        if (!fin) {
            v2u* b2 = (v2u*)(HB + (size_t)r * DM) + lane;
#pragma unroll
            for (int j = 0; j < 4; ++j) { const f32x4 o = v[j] * rstd * g4[j] + b4[j]; p[64 * j] = o; v2u w; w.x = pk2(o.x, o.y); w.y = pk2(o.z, o.w); b2[64 * j] = w; }
        } else {
            const int b = r / LTOK, t = r % LTOK;
            if (t >= NMETA) { f32x4* o4 = (f32x4*)(out + ((size_t)b * SEQ + (t - NMETA)) * DM) + lane;
#pragma unroll
                for (int j = 0; j < 4; ++j) o4[64 * j] = v[j] * rstd * g4[j] + b4[j]; }
        }
    }
}

__device__ __forceinline__ float gelu_tanh(float x) {
    const float u = 0.7978845608028654f * (x + 0.044715f * x * x * x);
    return x * __builtin_amdgcn_rcpf(1.0f + __builtin_amdgcn_exp2f(-2.0f * 1.4426950408889634f * u));
}
__device__ __forceinline__ float sigmoid_f(float x) { return __builtin_amdgcn_rcpf(1.0f + __builtin_amdgcn_exp2f(-1.4426950408889634f * x)); }
constexpr int REC_CH = 128, REC_NCH = (LTOK + REC_CH - 1) / REC_CH;
constexpr int SJ = 145;
__device__ __forceinline__ void rec_unit(LAS unsigned char* lds, const Args& a, int l, int b, int hb, int jh, const bf16* proj, bf16* ymix, float* stats, int tid, int wave, int lane) {
    LAS bf16* XC = (LAS bf16*)lds;
    LAS float* RA = (LAS float*)(lds + 18432);
    LAS float* IX = RA + 32 * SJ;
    LAS float* XF = IX + 32 * SJ;
    LAS float* HT = XF + 32 * SJ;
    const float* conv_w = a.in[8] + (size_t)l * 4 * 512; const float* conv_b = a.in[9] + (size_t)l * 512;
    const float* ga_w = a.in[10] + ((size_t)l * 8 + hb) * 4096; const float* ga_b = a.in[11] + (size_t)l * 512;
    const float* gx_w = a.in[12] + ((size_t)l * 8 + hb) * 4096; const float* gx_b = a.in[13] + (size_t)l * 512;
    const float* lam = a.in[14] + (size_t)l * 512; const float* g_rec = a.in[16] + (size_t)l * 512;
    const int hi = lane >> 5, l31 = lane & 31;
    const int seg = tid & 7, c0 = hb * 64 + seg * 8;
    float cw[4][8], cb[8];
#pragma unroll
    for (int e = 0; e < 8; ++e) { cb[e] = conv_b[c0 + e];
#pragma unroll
        for (int k = 0; k < 4; ++k) cw[k][e] = conv_w[k * 512 + c0 + e]; }
    const int rt = wave >> 1, gt = wave & 1;
    const float* gw_ = gt ? gx_w : ga_w;
    bf16x8 bfr[4];
#pragma unroll
    for (int ks = 0; ks < 4; ++ks) { unsigned w[4];
#pragma unroll
        for (int e = 0; e < 4; ++e) { const int k = 16 * ks + 8 * hi + 2 * e; w[e] = pk2(gw_[k * 64 + jh * 32 + l31], gw_[(k + 1) * 64 + jh * 32 + l31]); }
        v4u t; t.x = w[0]; t.y = w[1]; t.z = w[2]; t.w = w[3]; bfr[ks] = __builtin_bit_cast(bf16x8, t); }
    const float gbias = (gt ? gx_b : ga_b)[hb * 64 + jh * 32 + l31];
    const int sj = 4 * wave + (lane >> 4), ss_ = lane & 15, sc = hb * 64 + jh * 32 + sj;
    float cj;
    { const float x = __expf(-lam[sc]);
      const float sp = x < 0.05f ? x * (1.0f + x * (-0.5f + x * ((1.0f / 3.0f) + x * (-0.25f + x * 0.2f)))) : __logf(1.0f + x);
      cj = -8.0f * sp; }
    float hprev = 0.f;
    const int wt = tid >> 2, wq = tid & 3, wc0 = hb * 64 + jh * 32 + wq * 8;
    float gr[8];
#pragma unroll
    for (int e = 0; e < 8; ++e) gr[e] = g_rec[wc0 + e];

    for (int ch = 0; ch < REC_NCH; ++ch) {
        const int t0 = ch * REC_CH;
        v4u gatev = (v4u){0u, 0u, 0u, 0u};
        if (t0 + wt < LTOK) gatev = *(const v4u*)(proj + (size_t)row_of(b, t0 + wt) * DIN + 512 + wc0);
#pragma unroll
        for (int it = 0; it < 2; ++it) {
            const int tt = (tid >> 3) + 64 * it, t = t0 + tt;
            float o[8];
#pragma unroll
            for (int e = 0; e < 8; ++e) o[e] = cb[e];
            if (t < LTOK) {
#pragma unroll
                for (int k = 0; k < 4; ++k) { const int ts = t - 3 + k;
                    if (ts >= 0) { const v4u x = *(const v4u*)(proj + (size_t)row_of(b, ts) * DIN + c0);
                        o[0] += cw[k][0] * bflo(x.x); o[1] += cw[k][1] * bfhi(x.x); o[2] += cw[k][2] * bflo(x.y); o[3] += cw[k][3] * bfhi(x.y);
                        o[4] += cw[k][4] * bflo(x.z); o[5] += cw[k][5] * bfhi(x.z); o[6] += cw[k][6] * bflo(x.w); o[7] += cw[k][7] * bfhi(x.w); } }
            } else {
#pragma unroll
                for (int e = 0; e < 8; ++e) o[e] = 0.f;
            }
            v4u w; w.x = pk2(o[0], o[1]); w.y = pk2(o[2], o[3]); w.z = pk2(o[4], o[5]); w.w = pk2(o[6], o[7]);
            *(LAS v4u*)(XC + tt * 72 + seg * 8) = w;
            if ((seg >> 2) == jh) {
#pragma unroll
                for (int e = 0; e < 8; ++e) XF[((seg & 3) * 8 + e) * SJ + (tt >> 3) * 9 + (tt & 7)] = o[e];
            }
        }
        __syncthreads();
        {
            f32x16 acc;
#pragma unroll
            for (int i = 0; i < 16; ++i) acc[i] = 0.f;
#pragma unroll
            for (int ks = 0; ks < 4; ++ks) { const bf16x8 af = *(const LAS bf16x8*)(XC + (32 * rt + l31) * 72 + 16 * ks + 8 * hi);
                acc = __builtin_amdgcn_mfma_f32_32x32x16_bf16(af, bfr[ks], acc, 0, 0, 0); }
            LAS float* G = gt ? IX : RA;
#pragma unroll
            for (int i = 0; i < 16; ++i) { const int tt = 32 * rt + crow(i, hi); G[l31 * SJ + (tt >> 3) * 9 + (tt & 7)] = sigmoid_f(acc[i] + gbias); }
        }
        __syncthreads();
        {
            float av[8], gv[8]; float A = 1.f, H = 0.f;
            const int base = sj * SJ + ss_ * 9;
#pragma unroll
            for (int i = 0; i < 8; ++i) {
                const float ra = RA[base + i], ix = IX[base + i], xf = XF[base + i];
                const float la = cj * ra; const float ai = __expf(la);
                const float x2 = 2.0f * la;
                const float em = (x2 > -0.02f) ? -x2 * (1.0f + x2 * (0.5f + x2 * (1.0f / 6.0f))) : 1.0f - ai * ai;
                const float gi = sqrtf(em) * (ix * xf);
                av[i] = ai; gv[i] = gi; A *= ai; H = ai * H + gi;
            }
#pragma unroll
            for (int d = 1; d < 16; d <<= 1) { const float Ao = __shfl_up(A, d, 16), Ho = __shfl_up(H, d, 16); if (ss_ >= d) { H = A * Ho + H; A = A * Ao; } }
            float Ae = __shfl_up(A, 1, 16), He = __shfl_up(H, 1, 16); if (ss_ == 0) { Ae = 1.f; He = 0.f; }
            float h = Ae * hprev + He;
            const float Al = __shfl(A, 15, 16), Hl = __shfl(H, 15, 16);
            hprev = Al * hprev + Hl;
#pragma unroll
            for (int i = 0; i < 8; ++i) { h = av[i] * h + gv[i]; HT[(ss_ * 8 + i) * 33 + sj] = h; }
        }
        __syncthreads();
        {
            const int t = t0 + wt;
            float y[8]; float s2 = 0.f;
            const float gf[8] = {bflo(gatev.x), bfhi(gatev.x), bflo(gatev.y), bfhi(gatev.y), bflo(gatev.z), bfhi(gatev.z), bflo(gatev.w), bfhi(gatev.w)};
#pragma unroll
            for (int e = 0; e < 8; ++e) { y[e] = HT[wt * 33 + wq * 8 + e] * gelu_tanh(gf[e]); s2 += y[e] * y[e]; }
            s2 += __shfl_xor(s2, 1); s2 += __shfl_xor(s2, 2);
            if (t < LTOK) {
                const int r = row_of(b, t);
                v4u w; w.x = pk2(y[0] * gr[0], y[1] * gr[1]); w.y = pk2(y[2] * gr[2], y[3] * gr[3]); w.z = pk2(y[4] * gr[4], y[5] * gr[5]); w.w = pk2(y[6] * gr[6], y[7] * gr[7]);
                *(v4u*)(ymix + (size_t)r * DM + wc0) = w;
                if (wq == 0) __hip_atomic_fetch_add(stats + 2 * (size_t)r, s2, __ATOMIC_RELAXED, __HIP_MEMORY_SCOPE_AGENT);
            }
        }
    }
    __syncthreads();
}

constexpr int KS_STR = 72, VT_STR = 296, PS_STR = 40;
constexpr int ATT_KS = 0, ATT_VT = 288 * KS_STR * 2, ATT_PS = ATT_VT + 64 * VT_STR * 2;
__device__ __forceinline__ void attn_unit(LAS unsigned char* lds, const Args& a, int l, int b, int j, int g, const bf16* proj, bf16* ymix, float* stats, const float* rope, int tid, int wave, int lane) {
    LAS bf16* KS = (LAS bf16*)(lds + ATT_KS);
    LAS bf16* VT = (LAS bf16*)(lds + ATT_VT);
    LAS bf16* PS = (LAS bf16*)(lds + ATT_PS + wave * (32 * PS_STR * 2));
    const float* sinks = a.in[15] + l * 8; const float* g_attn = a.in[17] + (size_t)l * 512;
    const int hi = lane >> 5, l31 = lane & 31;
    const int kbase = NMETA + 128 * (j - 1);
    for (int it = tid; it < 288 * 4; it += NWAVES * 64) {
        const int kr = it >> 2, sg = it & 3;
        const int pos = kr < 32 ? kr : kbase + (kr - 32);
        const bool valid = (kr < NMETA) || (kr >= 32 && pos >= NMETA);
        v4u w0 = (v4u){0u, 0u, 0u, 0u}, w1 = w0;
        if (valid) {
            const bf16* src = proj + (size_t)row_of(b, pos) * DIN + 1536 + g * 64 + sg * 16;
            w0 = *(const v4u*)src; w1 = *(const v4u*)(src + 8);
            if (sg == 0) {
                const f32x4 c0 = *(const f32x4*)(rope + pos * 16), c1 = *(const f32x4*)(rope + pos * 16 + 4), s0 = *(const f32x4*)(rope + pos * 16 + 8), s1 = *(const f32x4*)(rope + pos * 16 + 12);
                const float x1[8] = {bflo(w0.x), bfhi(w0.x), bflo(w0.y), bfhi(w0.y), bflo(w0.z), bfhi(w0.z), bflo(w0.w), bfhi(w0.w)};
                const float x2[8] = {bflo(w1.x), bfhi(w1.x), bflo(w1.y), bfhi(w1.y), bflo(w1.z), bfhi(w1.z), bflo(w1.w), bfhi(w1.w)};
                const float cc[8] = {c0.x, c0.y, c0.z, c0.w, c1.x, c1.y, c1.z, c1.w}, sn[8] = {s0.x, s0.y, s0.z, s0.w, s1.x, s1.y, s1.z, s1.w};
                float o1[8], o2[8];
#pragma unroll
                for (int e = 0; e < 8; ++e) { o1[e] = x1[e] * cc[e] - x2[e] * sn[e]; o2[e] = x2[e] * cc[e] + x1[e] * sn[e]; }
                w0.x = pk2(o1[0], o1[1]); w0.y = pk2(o1[2], o1[3]); w0.z = pk2(o1[4], o1[5]); w0.w = pk2(o1[6], o1[7]);
                w1.x = pk2(o2[0], o2[1]); w1.y = pk2(o2[2], o2[3]); w1.z = pk2(o2[4], o2[5]); w1.w = pk2(o2[6], o2[7]);
            }
        }
        *(LAS v4u*)(KS + kr * KS_STR + sg * 16) = w0; *(LAS v4u*)(KS + kr * KS_STR + sg * 16 + 8) = w1;
    }
    for (int it = tid; it < 288 * 8; it += NWAVES * 64) {
        const int kr = it % 288, sg = it / 288;
        const int pos = kr < 32 ? kr : kbase + (kr - 32);
        const bool valid = (kr < NMETA) || (kr >= 32 && pos >= NMETA);
        v4u w = (v4u){0u, 0u, 0u, 0u};
        if (valid) w = *(const v4u*)(proj + (size_t)row_of(b, pos) * DIN + 1664 + g * 64 + sg * 8);
        LAS bf16* d = VT + (sg * 8) * VT_STR + kr;
        d[0 * VT_STR] = (bf16)(w.x & 0xffff); d[1 * VT_STR] = (bf16)(w.x >> 16); d[2 * VT_STR] = (bf16)(w.y & 0xffff); d[3 * VT_STR] = (bf16)(w.y >> 16);
        d[4 * VT_STR] = (bf16)(w.z & 0xffff); d[5 * VT_STR] = (bf16)(w.z >> 16); d[6 * VT_STR] = (bf16)(w.w & 0xffff); d[7 * VT_STR] = (bf16)(w.w >> 16);
    }
    __syncthreads();
    const int NT = 4 * (j == 0 ? 5 : 4);
    for (int wtile = wave; wtile < NT; wtile += NWAVES) {
        const int hq = wtile & 3, qt = wtile >> 2, h = 4 * g + hq;
        const int tq0 = qt < 4 ? NMETA + 128 * j + 32 * qt : 0;
        const int btb = qt < 4 ? qt : 0;
        const float sink = sinks[h];
        bf16x8 qf[4];
        {
            const int tq = tq0 + l31;
            const bf16* src = proj + (size_t)row_of(b, tq) * DIN + 1024 + h * 64;
            const v4u wa = *(const v4u*)src, wb = *(const v4u*)(src + 8);
            const f32x4 c0 = *(const f32x4*)(rope + tq * 16), c1 = *(const f32x4*)(rope + tq * 16 + 4), s0 = *(const f32x4*)(rope + tq * 16 + 8), s1 = *(const f32x4*)(rope + tq * 16 + 12);
            const float x1[8] = {bflo(wa.x), bfhi(wa.x), bflo(wa.y), bfhi(wa.y), bflo(wa.z), bfhi(wa.z), bflo(wa.w), bfhi(wa.w)};
            const float x2[8] = {bflo(wb.x), bfhi(wb.x), bflo(wb.y), bfhi(wb.y), bflo(wb.z), bfhi(wb.z), bflo(wb.w), bfhi(wb.w)};
            const float cc[8] = {c0.x, c0.y, c0.z, c0.w, c1.x, c1.y, c1.z, c1.w}, sn[8] = {s0.x, s0.y, s0.z, s0.w, s1.x, s1.y, s1.z, s1.w};
            float o[8];
#pragma unroll
            for (int e = 0; e < 8; ++e) o[e] = 0.125f * (hi == 0 ? x1[e] * cc[e] - x2[e] * sn[e] : x2[e] * cc[e] + x1[e] * sn[e]);
            v4u t; t.x = pk2(o[0], o[1]); t.y = pk2(o[2], o[3]); t.z = pk2(o[4], o[5]); t.w = pk2(o[6], o[7]); qf[0] = __builtin_bit_cast(bf16x8, t);
#pragma unroll
            for (int ks = 1; ks < 4; ++ks) { const v4u w = *(const v4u*)(src + 16 * ks + 8 * hi);
                v4u u; u.x = pk2(0.125f * bflo(w.x), 0.125f * bfhi(w.x)); u.y = pk2(0.125f * bflo(w.y), 0.125f * bfhi(w.y)); u.z = pk2(0.125f * bflo(w.z), 0.125f * bfhi(w.z)); u.w = pk2(0.125f * bflo(w.w), 0.125f * bfhi(w.w));
                qf[ks] = __builtin_bit_cast(bf16x8, u); }
        }
        f32x16 S[6];
#pragma unroll
        for (int kt = 0; kt < 6; ++kt) {
            const int kr0 = kt == 0 ? 0 : 32 + 32 * (btb + kt - 1);
            f32x16 acc;
#pragma unroll
            for (int i = 0; i < 16; ++i) acc[i] = 0.f;
#pragma unroll
            for (int ks = 0; ks < 4; ++ks) { const bf16x8 kf = *(const LAS bf16x8*)(KS + (kr0 + l31) * KS_STR + 16 * ks + 8 * hi);
                acc = __builtin_amdgcn_mfma_f32_32x32x16_bf16(qf[ks], kf, acc, 0, 0, 0); }
            const int tk = kt == 0 ? l31 : kbase + 32 * (btb + kt - 1) + l31;
#pragma unroll
            for (int i = 0; i < 16; ++i) { const int tq = tq0 + crow(i, hi);
                const bool ok = kt == 0 ? (l31 < NMETA && tk <= tq) : (tk >= NMETA && tk <= tq && tq - tk < 128);
                acc[i] = ok ? acc[i] : -1e30f; }
            S[kt] = acc;
        }
        float inv[16];
#pragma unroll
        for (int i = 0; i < 16; ++i) {
            float m = S[0][i];
#pragma unroll
            for (int kt = 1; kt < 6; ++kt) m = fmaxf(m, S[kt][i]);
#pragma unroll
            for (int o = 1; o < 32; o <<= 1) m = fmaxf(m, __shfl_xor(m, o));
            m = fmaxf(m, sink);
            float s = 0.f;
#pragma unroll
            for (int kt = 0; kt < 6; ++kt) { const float p = __expf(S[kt][i] - m); S[kt][i] = p; s += p; }
#pragma unroll
            for (int o = 1; o < 32; o <<= 1) s += __shfl_xor(s, o);
            inv[i] = 1.0f / (s + __expf(sink - m));
        }
        f32x16 O0, O1;
#pragma unroll
        for (int i = 0; i < 16; ++i) { O0[i] = 0.f; O1[i] = 0.f; }
#pragma unroll
        for (int kt = 0; kt < 6; ++kt) {
            const int kr0 = kt == 0 ? 0 : 32 + 32 * (btb + kt - 1);
#pragma unroll
            for (int i = 0; i < 16; ++i) PS[crow(i, hi) * PS_STR + l31] = (bf16)(pk2(S[kt][i] * inv[i], 0.f) & 0xffff);
            LDS_WAIT();
#pragma unroll
            for (int k2 = 0; k2 < 2; ++k2) {
                const bf16x8 pf = *(const LAS bf16x8*)(PS + l31 * PS_STR + 16 * k2 + 8 * hi);
                const bf16x8 v0 = *(const LAS bf16x8*)(VT + l31 * VT_STR + kr0 + 16 * k2 + 8 * hi);
                const bf16x8 v1 = *(const LAS bf16x8*)(VT + (32 + l31) * VT_STR + kr0 + 16 * k2 + 8 * hi);
                O0 = __builtin_amdgcn_mfma_f32_32x32x16_bf16(pf, v0, O0, 0, 0, 0);
                O1 = __builtin_amdgcn_mfma_f32_32x32x16_bf16(pf, v1, O1, 0, 0, 0);
            }
            LDS_WAIT();
        }
        const float ga0 = g_attn[h * 64 + l31], ga1 = g_attn[h * 64 + 32 + l31];
#pragma unroll
        for (int i = 0; i < 16; ++i) {
            const int tq = tq0 + crow(i, hi);
            float s2 = O0[i] * O0[i] + O1[i] * O1[i];
#pragma unroll
            for (int o = 1; o < 32; o <<= 1) s2 += __shfl_xor(s2, o);
            const bool ok = qt < 4 || tq < NMETA;
            if (ok) {
                const int r = row_of(b, tq);
                bf16* dst = ymix + (size_t)r * DM + 512 + h * 64;
                dst[l31] = (bf16)(pk2(O0[i] * ga0, 0.f) & 0xffff); dst[32 + l31] = (bf16)(pk2(O1[i] * ga1, 0.f) & 0xffff);
                if (l31 == 0) __hip_atomic_fetch_add(stats + 2 * (size_t)r + 1, s2, __ATOMIC_RELAXED, __HIP_MEMORY_SCOPE_AGENT);
            }
        }
    }
    __syncthreads();
}

constexpr int N_PHASES = 1 + 10 * DEPTH;
__global__ void __launch_bounds__(NWAVES * 64, 2) fwd_kernel(Args args) {
    extern __shared__ __attribute__((aligned(16))) unsigned char lds_raw[];
    LAS unsigned char* lds = (LAS unsigned char*)lds_raw;
    cg::grid_group grid = cg::this_grid();
    const int G = gridDim.x, bx = blockIdx.x;
    const int vcu = (G % 8 == 0) ? (bx % 8) * (G / 8) + bx / 8 : bx;
    const int NGW = G * NWAVES;
    unsigned char* ws = args.ws;
    float* HF = (float*)(ws + WS_HF);
    bf16* HB = (bf16*)args.out;
    bf16* ACT = (bf16*)(ws + WS_ACT); bf16* PROJ = (bf16*)(ws + WS_PROJ); bf16* YMIX = (bf16*)(ws + WS_YMIX);
    const float* rope = (const float*)(ws + WS_ROPE);

    for (int p = args.ph_lo; p < args.ph_hi; ++p) {
        int tid_ = threadIdx.x; asm volatile("" : "+v"(tid_));
        const int tid = tid_, lane = tid & 63, wave = __builtin_amdgcn_readfirstlane(tid >> 6), gw = vcu * NWAVES + wave;
        if (p == 0) {
            prologue(args, lds, HB, gw, NGW, wave, lane);
        } else {
            const int l = (p - 1) / 10, s = (p - 1) % 10;
            const bf16* Wl = (const bf16*)(ws + WS_W) + (size_t)l * W_LAYER;
            float* stats = (float*)(ws + WS_STATS) + (size_t)l * MT * 2;
            if (s == 0 || s == 7) {
                pg8::Gemm g{HB, Wl + (s == 0 ? OFF_GU1 : OFF_GU2), MT, 2 * DFF, DM}; pg8::StaticOrder S; S.init(MT, 2 * DFF, G, bx);
                pg8::EpiSwiGLU E{ACT, DFF};
                pg8::gemm_phase<pg8::EpiSwiGLU, pg8::StaticOrder, true, true>(lds, g, S, E);
            } else if (s == 1 || s == 8) {
                pg8::Gemm g{ACT, Wl + (s == 1 ? OFF_D1 : OFF_D2), MT, DM, DFF}; pg8::StaticOrder S; S.init(MT, DM, G, bx);
                pg8::EpiRes<false> E{HF, DM, DN_ALPHA, 0.5f, nullptr};
                pg8::gemm_phase<pg8::EpiRes<false>, pg8::StaticOrder, true, true>(lds, g, S, E);
            } else if (s == 2 || s == 6 || s == 9) {
                const int gi = s == 2 ? 5 : (s == 6 ? 19 : 24);
                ln_rows(args.in[gi] + (size_t)l * DM, args.in[gi + 1] + (size_t)l * DM, HF, HB, args.out, (l == DEPTH - 1 && s == 9), gw, NGW, lane);
            } else if (s == 3) {
                pg8::Gemm g{HB, Wl + OFF_IN, MT, DIN, DM}; pg8::StaticOrder S; S.init(MT, DIN, G, bx);
                pg8::EpiStore E{PROJ, DIN};
                pg8::gemm_phase<pg8::EpiStore, pg8::StaticOrder, true, true>(lds, g, S, E);
            } else if (s == 4) {
                for (int u = bx; u < 256 + 512; u += G) {
                    if (u < 256) rec_unit(lds, args, l, u >> 4, (u >> 1) & 7, u & 1, PROJ, YMIX, stats, tid, wave, lane);
                    else { const int v = u - 256; attn_unit(lds, args, l, v >> 5, (v >> 1) & 15, v & 1, PROJ, YMIX, stats, rope, tid, wave, lane); }
                }
            } else {
                pg8::Gemm g{YMIX, Wl + OFF_OUT, MT, DM, DM}; pg8::StaticOrder S; S.init(MT, DM, G, bx);
                pg8::EpiRes<true> E{HF, DM, DN_ALPHA, 1.0f, stats};
                pg8::gemm_phase<pg8::EpiRes<true>, pg8::StaticOrder, true, true>(lds, g, S, E);
            }
        }
        if (p + 1 < args.ph_hi) grid.sync();
    }
}

extern "C" void kernel_launch(void* const* d_in, const int* in_sizes, int n_in, void* d_out, int out_size, void* d_ws, size_t ws_size, hipStream_t stream) {
    static int grid = 0;
    if (grid == 0) {
        if (n_in != 26 || ws_size < WS_END || (size_t)out_size * 4 < (size_t)MT * DM * 2) { fprintf(stderr, "kernel_launch: unexpected sizes n_in %d ws %zu out %d\n", n_in, ws_size, out_size); grid = -1; return; }
        int dev = 0, cus = 0, per_cu = 0;
        hipGetDevice(&dev); hipDeviceGetAttribute(&cus, hipDeviceAttributeMultiprocessorCount, dev);
        if (hipFuncSetAttribute((const void*)fwd_kernel, hipFuncAttributeMaxDynamicSharedMemorySize, LDS_BYTES) != hipSuccess) { fprintf(stderr, "kernel_launch: hipFuncSetAttribute failed\n"); grid = -1; return; }
        if (hipOccupancyMaxActiveBlocksPerMultiprocessor(&per_cu, (const void*)fwd_kernel, NWAVES * 64, LDS_BYTES) != hipSuccess || per_cu < 1) { fprintf(stderr, "kernel_launch: occupancy query says %d\n", per_cu); per_cu = 1; }
        (void)hipGetLastError();
        grid = cus * 1;
    }
    if (grid < 0) return;
    hipMemsetAsync((char*)d_ws + WS_CTL, 0, CTL_BYTES, stream);
    Args a{};
    for (int i = 0; i < 26; ++i) a.in[i] = (const float*)d_in[i];
    a.out = (float*)d_out; a.ws = (unsigned char*)d_ws;
#if MK_LAUNCH_PER_PHASE
    for (int p = 0; p < N_PHASES; ++p) {
        a.ph_lo = p; a.ph_hi = p + 1; void* kargs[] = {&a};
        hipError_t e = hipLaunchCooperativeKernel((const void*)fwd_kernel, dim3(grid), dim3(NWAVES * 64), kargs, LDS_BYTES, stream);
        if (e != hipSuccess) { fprintf(stderr, "launch %d failed: %s\n", p, hipGetErrorString(e)); break; }
    }
#else
    a.ph_lo = 0; a.ph_hi = N_PHASES; void* kargs[] = {&a};
    hipError_t e = hipLaunchCooperativeKernel((const void*)fwd_kernel, dim3(grid), dim3(NWAVES * 64), kargs, LDS_BYTES, stream);
    if (e != hipSuccess) fprintf(stderr, "cooperative launch failed: %s (grid %d)\n", hipGetErrorString(e), grid);
#endif
}
```

```cpp
#include <hip/hip_runtime.h>
#include <hip/hip_cooperative_groups.h>
#include <cstdio>
#include <cstdint>
namespace cg = cooperative_groups;
namespace pg8 {
#define PG8_LAS __attribute__((address_space(3)))
typedef unsigned short bf16_t;
typedef short bf16x8 __attribute__((ext_vector_type(8)));
typedef float f32x4 __attribute__((ext_vector_type(4)));
typedef unsigned u32x4 __attribute__((ext_vector_type(4)));
constexpr int BM = 256, BK = 64, HALF = 128, HTB = HALF * BK * 2  , STAGE_BYTES = 8 * HTB, NXCD = 8, WGM = 8;

__host__ __device__ __forceinline__ int lds_byte(int r, int c) { const int st = (r >> 4) * 2 + (c >> 5), rr = r & 15, cc = c & 31, ob = rr * 64 + cc * 2; return st * 1024 + (ob ^ (((ob >> 9) & 1) << 5)); }
__host__ __device__ __forceinline__ void stage_rc(int b, int& R, int& C) { const int st = b / 1024, sb = b % 1024, swz = sb ^ (((sb >> 9) & 1) << 5); R = (st >> 1) * 16 + swz / 64; C = (st & 1) * 32 + (swz % 64) / 2; }
__host__ __device__ __forceinline__ int perm32(int rho) { const int n = rho >> 4, i = rho & 15; return 8 * (i >> 2) + 4 * n + (i & 3); }

struct Unit { int pm, pn; };
struct Gemm { const bf16_t* A; const bf16_t* Bt; int M, N, K; };

struct StaticOrder {
    int nM, nN, nwg, G, c;
    __host__ __device__ void init(int M, int N, int G_, int c_) { nM = M / BM; nN = N / BM; nwg = nM * nN; G = G_; c = c_; }
    __host__ __device__ bool next(int i, Unit& u) const {
        const long L = (long)i * G + c; if (L >= nwg) return false;
        int wgid = (int)L; { const int q = nwg / NXCD, r = nwg % NXCD, xcd = wgid % NXCD, off = wgid / NXCD; wgid = (xcd < r ? xcd * (q + 1) : r * (q + 1) + (xcd - r) * q) + off; }
        const int nig = WGM * nN, gid = wgid / nig, fm = gid * WGM, gsz = (nM - fm) < WGM ? (nM - fm) : WGM;
        u.pm = fm + ((wgid % nig) % gsz); u.pn = (wgid % nig) / gsz; return true;
    }
    __device__ __forceinline__ void a_ready(const Unit&) const {}
    __device__ __forceinline__ void done(const Unit&) const {}
};

__device__ __forceinline__ unsigned cvt_pk_bf16(float lo, float hi) { unsigned r; asm volatile("v_cvt_pk_bf16_f32 %0, %1, %2" : "=v"(r) : "v"(lo), "v"(hi)); return r; }
typedef float f32x2 __attribute__((ext_vector_type(2)));
template <class Epi, class Sched, bool ALIGN_EPI = false, bool SP2 = false>
__device__ __forceinline__ void gemm_phase(PG8_LAS unsigned char* lds, const Gemm g, const Sched& S, const Epi& E) {
    int tid_ = threadIdx.x; asm volatile("" : "+v"(tid_));
    const int tid = tid_, wid = __builtin_amdgcn_readfirstlane(tid >> 6), lane = tid & 63, wr = wid >> 2, wc = wid & 3, fr = lane & 15, fq = lane >> 4;
    const int K = g.K, nt = K / BK;
    unsigned voffA[2], voffB[2];
#pragma unroll
    for (int i = 0; i < 2; ++i) { int R, C; stage_rc(tid * 16 + i * 8192, R, C); const int Rb = Epi::PERM ? ((R & ~31) + perm32(R & 31)) : R;
        voffA[i] = (unsigned)(R * K + C) * 2u; voffB[i] = (unsigned)(Rb * K + C) * 2u; }
    const size_t kstep = (size_t)(BK * 2);
    const size_t hstep = (size_t)HALF * K * 2;
    const size_t tstep = 2 * hstep;
    const unsigned ldsw = (unsigned)wid * 1024u;
    const int aoff = lds_byte(wr * 64 + fr, fq * 8), boff = lds_byte(wc * 32 + fr, fq * 8);
#define PG8_SA(b, h) (((b) * 2 + (h)) * HTB)
#define PG8_SB(b, h) ((4 + (b) * 2 + (h)) * HTB)
#define PG8_STAGE(bufoff, gbase, voff) do { _Pragma("unroll") for (int _i = 0; _i < 2; ++_i) \
        __builtin_amdgcn_global_load_lds((const unsigned*)((const char*)(gbase) + (voff)[_i]), (PG8_LAS unsigned*)(lds + (bufoff) + ldsw + _i * 8192), 16, 0, 0); } while (0)
#define PG8_LDA(dst, b, h) do { _Pragma("unroll") for (int m = 0; m < 4; ++m) _Pragma("unroll") for (int k = 0; k < 2; ++k) dst[m][k] = *(const PG8_LAS bf16x8*)(lds + PG8_SA(b, h) + aoff + m * 2048 + k * 1024); } while (0)
#define PG8_LDB(dst, b, h) do { _Pragma("unroll") for (int n = 0; n < 2; ++n) _Pragma("unroll") for (int k = 0; k < 2; ++k) dst[n][k] = *(const PG8_LAS bf16x8*)(lds + PG8_SB(b, h) + boff + n * 2048 + k * 1024); } while (0)
#define PG8_MMA(ai, bj, At, Bt) do { __builtin_amdgcn_s_setprio(1); _Pragma("unroll") for (int m = 0; m < 4; ++m) _Pragma("unroll") for (int n = 0; n < 2; ++n) _Pragma("unroll") for (int k = 0; k < 2; ++k) \
        acc[ai][bj][m][n] = __builtin_amdgcn_mfma_f32_16x16x32_bf16(Bt[n][k], At[m][k], acc[ai][bj][m][n], 0, 0, 0); __builtin_amdgcn_s_setprio(0); } while (0)
#define PG8_WAIT_V(n) asm volatile("s_waitcnt vmcnt(" #n ")" ::: "memory")
#define PG8_WAIT_L(n) asm volatile("s_waitcnt lgkmcnt(" #n ")" ::: "memory")
#define PG8_BAR __builtin_amdgcn_s_barrier()
#define PG8_SCHED __builtin_amdgcn_sched_barrier(0)
    Unit cur, nxt; int ui = 0;
    if (!S.next(0, cur)) return;
    f32x4 acc[2][2][4][2];
#pragma unroll
    for (int a = 0; a < 2; ++a)
#pragma unroll
        for (int b = 0; b < 2; ++b)
#pragma unroll
            for (int m = 0; m < 4; ++m)
#pragma unroll
                for (int n = 0; n < 2; ++n) acc[a][b][m][n] = (f32x4){0.f, 0.f, 0.f, 0.f};
    bf16x8 At[4][2], B0[2][2], B1[2][2];
    const char* cA = (const char*)g.A + (size_t)cur.pm * tstep; const char* cB = (const char*)g.Bt + (size_t)cur.pn * tstep;
    S.a_ready(cur);
    if constexpr (SP2) {
        PG8_STAGE(PG8_SB(0, 0), cB, voffB); PG8_STAGE(PG8_SB(0, 1), cB + hstep, voffB); PG8_STAGE(PG8_SA(0, 0), cA, voffA); PG8_STAGE(PG8_SA(0, 1), cA + hstep, voffA);
        if (wr == 1) PG8_BAR;
        PG8_WAIT_V(2); PG8_BAR;
        PG8_STAGE(PG8_SB(1, 0), cB + kstep, voffB); PG8_STAGE(PG8_SA(1, 0), cA + kstep, voffA); PG8_STAGE(PG8_SB(1, 1), cB + hstep + kstep, voffB);
        PG8_WAIT_V(6); PG8_BAR;
    } else {
        PG8_STAGE(PG8_SB(0, 0), cB, voffB); PG8_STAGE(PG8_SA(0, 0), cA, voffA); PG8_STAGE(PG8_SB(0, 1), cB + hstep, voffB); PG8_STAGE(PG8_SA(0, 1), cA + hstep, voffA);
        if (wr == 1) PG8_BAR;
        PG8_WAIT_V(4); PG8_BAR;
        PG8_STAGE(PG8_SB(1, 0), cB + kstep, voffB); PG8_STAGE(PG8_SA(1, 0), cA + kstep, voffA); PG8_STAGE(PG8_SB(1, 1), cB + hstep + kstep, voffB);
        PG8_WAIT_V(6); PG8_BAR;
    }
    for (;;) {
        const bool has_next = S.next(ui + 1, nxt);
        const char* nA = has_next ? (const char*)g.A + (size_t)nxt.pm * tstep : cA; const char* nB = has_next ? (const char*)g.Bt + (size_t)nxt.pn * tstep : cB;
        for (int t = 0; t < nt; t += 2) {
            const bool last = (t == nt - 2);
            if constexpr (Epi::MID) { if (t == (nt >> 1)) E.mid(acc, cur, wr, wc, fr, fq); }
            const char* a1 = cA + (size_t)(t + 1) * kstep;
            const char* a2 = last ? nA : cA + (size_t)(t + 2) * kstep; const char* b2 = last ? nB : cB + (size_t)(t + 2) * kstep;
            const char* a3 = a2 + kstep; const char* b3 = b2 + kstep;
            if (last && has_next) S.a_ready(nxt);
            if constexpr (SP2) {
            PG8_LDB(B0, 0, 0); PG8_LDB(B1, 0, 1); PG8_SCHED; PG8_LDA(At, 0, 0); PG8_STAGE(PG8_SA(1, 1), a1 + hstep, voffA);
            PG8_WAIT_V(8); PG8_WAIT_L(0); PG8_BAR; PG8_MMA(0, 0, At, B0); PG8_MMA(0, 1, At, B1); PG8_BAR; PG8_SCHED;
            PG8_LDA(At, 0, 1); PG8_STAGE(PG8_SB(0, 0), b2, voffB); PG8_STAGE(PG8_SB(0, 1), b2 + hstep, voffB); PG8_STAGE(PG8_SA(0, 0), a2, voffA);
            PG8_WAIT_V(8); PG8_WAIT_L(0); PG8_BAR; PG8_MMA(1, 0, At, B0); PG8_MMA(1, 1, At, B1); PG8_BAR; PG8_SCHED;
            PG8_LDB(B0, 1, 0); PG8_LDB(B1, 1, 1); PG8_SCHED; PG8_LDA(At, 1, 0); PG8_STAGE(PG8_SA(0, 1), a2 + hstep, voffA);
            PG8_WAIT_V(8); PG8_WAIT_L(0); PG8_BAR; PG8_MMA(0, 0, At, B0); PG8_MMA(0, 1, At, B1); PG8_BAR; PG8_SCHED;
            PG8_LDA(At, 1, 1); PG8_STAGE(PG8_SB(1, 0), b3, voffB); PG8_STAGE(PG8_SB(1, 1), b3 + hstep, voffB); PG8_STAGE(PG8_SA(1, 0), a3, voffA);
            PG8_WAIT_V(8); PG8_WAIT_L(0); PG8_BAR; PG8_MMA(1, 0, At, B0); PG8_MMA(1, 1, At, B1); PG8_BAR; PG8_SCHED;
            } else {
            PG8_LDB(B0, 0, 0); PG8_SCHED; PG8_LDA(At, 0, 0); PG8_STAGE(PG8_SA(1, 1), a1 + hstep, voffA);
            PG8_WAIT_L(8); PG8_BAR; PG8_WAIT_L(0); PG8_MMA(0, 0, At, B0); PG8_BAR; PG8_SCHED;
            PG8_LDB(B1, 0, 1); PG8_STAGE(PG8_SB(0, 0), b2, voffB);
            PG8_BAR; PG8_WAIT_L(0); PG8_MMA(0, 1, At, B1); PG8_BAR;
            PG8_LDA(At, 0, 1); PG8_STAGE(PG8_SA(0, 0), a2, voffA);
            PG8_BAR; PG8_WAIT_L(0); PG8_MMA(1, 0, At, B0); PG8_BAR; PG8_SCHED;
            PG8_STAGE(PG8_SB(0, 1), b2 + hstep, voffB);
            PG8_WAIT_V(6); PG8_BAR; PG8_MMA(1, 1, At, B1); PG8_BAR;
            PG8_LDB(B0, 1, 0); PG8_SCHED; PG8_LDA(At, 1, 0); PG8_STAGE(PG8_SA(0, 1), a2 + hstep, voffA);
            PG8_WAIT_L(8); PG8_BAR; PG8_WAIT_L(0); PG8_MMA(0, 0, At, B0); PG8_BAR; PG8_SCHED;
            PG8_LDB(B1, 1, 1); PG8_STAGE(PG8_SB(1, 0), b3, voffB);
            PG8_BAR; PG8_WAIT_L(0); PG8_MMA(0, 1, At, B1); PG8_BAR;
            PG8_LDA(At, 1, 1); PG8_STAGE(PG8_SA(1, 0), a3, voffA);
            PG8_BAR; PG8_WAIT_L(0); PG8_MMA(1, 0, At, B0); PG8_BAR; PG8_SCHED;
            PG8_STAGE(PG8_SB(1, 1), b3 + hstep, voffB);
            PG8_WAIT_V(6); PG8_BAR; PG8_MMA(1, 1, At, B1); PG8_BAR;
            }
        }
        if constexpr (ALIGN_EPI) { if (wr == 0) PG8_BAR; }
        if constexpr (!Epi::AFTER_DRAIN) { E(acc, cur, wr, wc, fr, fq); S.done(cur); }
        if (!has_next) break;
#pragma unroll
        for (int a = 0; a < 2; ++a)
#pragma unroll
            for (int b = 0; b < 2; ++b)
#pragma unroll
                for (int m = 0; m < 4; ++m)
#pragma unroll
                    for (int n = 0; n < 2; ++n) acc[a][b][m][n] = (f32x4){0.f, 0.f, 0.f, 0.f};
        cur = nxt; cA = nA; cB = nB; ++ui;
        if constexpr (ALIGN_EPI) { if (wr == 1) PG8_BAR; }
    }
    PG8_WAIT_V(0);
    if constexpr (!ALIGN_EPI) { if (wr == 0) PG8_BAR; }
    PG8_BAR;
    if constexpr (Epi::AFTER_DRAIN) { E.fused(acc, cur, wr, wc, fr, fq, lds, wid, lane); S.done(cur); }
#undef PG8_SA
#undef PG8_SB
#undef PG8_STAGE
#undef PG8_LDA
#undef PG8_LDB
#undef PG8_MMA
#undef PG8_WAIT_V
#undef PG8_WAIT_L
#undef PG8_BAR
#undef PG8_SCHED
}

typedef unsigned u32x2 __attribute__((ext_vector_type(2)));
__device__ __forceinline__ float silu_f(float x) { return x * __builtin_amdgcn_rcpf(1.0f + __builtin_amdgcn_exp2f(-1.4426950408889634f * x)); }

struct EpiStore {
    static constexpr bool PERM = true, AFTER_DRAIN = false, MID = false;
    bf16_t* O; int ldc;
    __device__ __forceinline__ void mid(f32x4 (&)[2][2][4][2], const Unit&, int, int, int, int) const {}
    __device__ __forceinline__ void operator()(const f32x4 (&acc)[2][2][4][2], const Unit& u, int wr, int wc, int fr, int fq) const {
        const int row0 = u.pm * BM + wr * 64 + fr, col0 = u.pn * BM + wc * 32 + 8 * fq;
#pragma unroll
        for (int ai = 0; ai < 2; ++ai)
#pragma unroll
            for (int m = 0; m < 4; ++m) { bf16_t* rowp = O + (size_t)(row0 + ai * HALF + m * 16) * ldc + col0;
#pragma unroll
                for (int bj = 0; bj < 2; ++bj) { const f32x4 v0 = acc[ai][bj][m][0], v1 = acc[ai][bj][m][1];
                    u32x4 w; w.x = cvt_pk_bf16(v0[0], v0[1]); w.y = cvt_pk_bf16(v0[2], v0[3]); w.z = cvt_pk_bf16(v1[0], v1[1]); w.w = cvt_pk_bf16(v1[2], v1[3]);
                    *(u32x4*)(rowp + bj * HALF) = w; } }
    }
};
struct EpiSwiGLU {
    static constexpr bool PERM = true, AFTER_DRAIN = false, MID = false;
    bf16_t* O; int ldc;
    __device__ __forceinline__ void mid(f32x4 (&)[2][2][4][2], const Unit&, int, int, int, int) const {}
    __device__ __forceinline__ void operator()(const f32x4 (&acc)[2][2][4][2], const Unit& u, int wr, int wc, int fr, int fq) const {
        const int row0 = u.pm * BM + wr * 64 + fr, col0 = u.pn * HALF + wc * 32 + 8 * fq;
#pragma unroll
        for (int ai = 0; ai < 2; ++ai)
#pragma unroll
            for (int m = 0; m < 4; ++m) { bf16_t* rowp = O + (size_t)(row0 + ai * HALF + m * 16) * ldc + col0;
                const f32x4 g0 = acc[ai][0][m][0], g1 = acc[ai][0][m][1], u0 = acc[ai][1][m][0], u1 = acc[ai][1][m][1];
                u32x4 w;
                w.x = cvt_pk_bf16(silu_f(g0[0]) * u0[0], silu_f(g0[1]) * u0[1]); w.y = cvt_pk_bf16(silu_f(g0[2]) * u0[2], silu_f(g0[3]) * u0[3]);
                w.z = cvt_pk_bf16(silu_f(g1[0]) * u1[0], silu_f(g1[1]) * u1[1]); w.w = cvt_pk_bf16(silu_f(g1[2]) * u1[2], silu_f(g1[3]) * u1[3]);
                *(u32x4*)rowp = w; }
    }
};
template <bool STATS> struct EpiRes {
    static constexpr bool PERM = false, AFTER_DRAIN = false, MID = STATS;
    float* H; int ldc; float alpha, sc; const float* stats;
    __device__ __forceinline__ float rs(float ss) const { return __builtin_amdgcn_rsqf(ss * (1.0f / 512.0f) + 1e-6f); }
    __device__ __forceinline__ void mid(f32x4 (&acc)[2][2][4][2], const Unit& u, int wr, int wc, int fr, int fq) const {
        if constexpr (STATS) {
#pragma unroll
            for (int ai = 0; ai < 2; ++ai)
#pragma unroll
                for (int m = 0; m < 4; ++m) { const int r = u.pm * BM + ai * HALF + wr * 64 + m * 16 + fr;
                    const f32x2 st = *(const f32x2*)(stats + 2 * (size_t)r); const float s = rs(st.x) / rs(st.y);
#pragma unroll
                    for (int bj = 0; bj < 2; ++bj)
#pragma unroll
                        for (int n = 0; n < 2; ++n) acc[ai][bj][m][n] *= s;
                    asm volatile("" ::: "memory"); }
        }
    }
    __device__ __forceinline__ void operator()(const f32x4 (&acc)[2][2][4][2], const Unit& u, int wr, int wc, int fr, int fq) const {
        const int col0 = u.pn * BM + wc * 32 + 4 * fq;
#pragma unroll
        for (int ai = 0; ai < 2; ++ai)
#pragma unroll
            for (int m = 0; m < 4; ++m) { const int r = u.pm * BM + ai * HALF + wr * 64 + m * 16 + fr; float s = sc;
                if constexpr (STATS) { s = rs(stats[2 * (size_t)r + 1]); }
                float* rowp = H + (size_t)r * ldc + col0;
#pragma unroll
                for (int bj = 0; bj < 2; ++bj)
#pragma unroll
                    for (int n = 0; n < 2; ++n) { f32x4* p = (f32x4*)(rowp + bj * HALF + n * 16); const f32x4 h = *p; *p = h * alpha + acc[ai][bj][m][n] * s; } }
    }
};
}

constexpr int NWAVES = 8;
constexpr int BATCH = 16, SEQ = 2048, NMETA = 16, LTOK = SEQ + NMETA, DM = 1024, DFF = 2816, DIN = 1792, DEPTH = 4;
constexpr int MT = BATCH * LTOK;
constexpr float DN_ALPHA = 1.6817928305074290f;
constexpr float LN_EPS = 1e-5f;
#ifndef MK_LAUNCH_PER_PHASE
#define MK_LAUNCH_PER_PHASE 0
#endif
constexpr size_t MiB = 1u << 20;
constexpr size_t WS_CTL = 0, CTL_BYTES = 2 * MiB;
constexpr size_t WS_STATS = 65536;
constexpr size_t WS_ROPE = 2 * MiB;
constexpr size_t WS_W = 3 * MiB;
constexpr size_t W_GU = (size_t)2 * DFF * DM, W_D = (size_t)DM * DFF, W_IN = (size_t)DIN * DM, W_OUT = (size_t)DM * DM;
constexpr size_t W_LAYER = 2 * W_GU + 2 * W_D + W_IN + W_OUT;
constexpr size_t OFF_GU1 = 0, OFF_D1 = W_GU, OFF_IN = OFF_D1 + W_D, OFF_OUT = OFF_IN + W_IN, OFF_GU2 = OFF_OUT + W_OUT, OFF_D2 = OFF_GU2 + W_GU;
constexpr size_t WS_HF = WS_W + W_LAYER * 2 * DEPTH;
constexpr size_t WS_ACT = WS_HF + (size_t)MT * DM * 4;
constexpr size_t WS_PROJ = WS_ACT, WS_YMIX = WS_ACT + (size_t)MT * DIN * 2;
constexpr size_t WS_END = WS_ACT + (size_t)MT * DFF * 2;
static_assert(WS_YMIX + (size_t)MT * DM * 2 <= WS_END, "ws map");
static_assert(WS_STATS + (size_t)DEPTH * MT * 2 * 4 <= CTL_BYTES, "stats in ctl");
static_assert(WS_HF % 256 == 0 && WS_ACT % 256 == 0 && WS_YMIX % 256 == 0, "align");
constexpr int LDS_BYTES = 147456;

#define GAS __attribute__((address_space(1)))
#define LAS __attribute__((address_space(3)))
typedef unsigned short bf16;
typedef unsigned v4u __attribute__((ext_vector_type(4)));
typedef unsigned v2u __attribute__((ext_vector_type(2)));
typedef float f32x4 __attribute__((ext_vector_type(4)));
typedef float f32x16 __attribute__((ext_vector_type(16)));
typedef short bf16x8 __attribute__((ext_vector_type(8)));
#define LDS_WAIT() asm volatile("s_waitcnt lgkmcnt(0)" ::: "memory")
__device__ __forceinline__ unsigned pk2(float lo, float hi) { return pg8::cvt_pk_bf16(lo, hi); }
__device__ __forceinline__ float bflo(unsigned w) { return __uint_as_float(w << 16); }
__device__ __forceinline__ float bfhi(unsigned w) { return __uint_as_float(w & 0xffff0000u); }
__device__ __forceinline__ float wave_sum(float v) {
#pragma unroll
    for (int o = 1; o < 64; o <<= 1) v += __shfl_xor(v, o);
    return v;
}
__device__ __forceinline__ int crow(int r, int hi) { return (r & 3) + 8 * (r >> 2) + 4 * hi; }
__device__ __forceinline__ int row_of(int b, int t) { return b * LTOK + t; }

struct Args { const float* in[26]; float* out; unsigned char* ws; int ph_lo, ph_hi; };

__device__ __forceinline__ void transpose_item(const float* W, int K, int N, bf16* WT, int blk, int row_off, LAS float* scr, int item, int lane) {
    const int nblk = N / 32, kb = item / nblk, nb = item % nblk, k0 = 64 * kb, n0 = 32 * nb;
#pragma unroll 8
    for (int i = 0; i < 32; ++i) { const int kk = 2 * i + (lane >> 5); scr[kk * 33 + (lane & 31)] = W[(size_t)(k0 + kk) * N + n0 + (lane & 31)]; }
    LDS_WAIT();
    const int c = lane & 7;
#pragma unroll
    for (int j = 0; j < 4; ++j) { const int n = (lane >> 3) + 8 * j; const LAS float* s = scr + (8 * c) * 33 + n;
        v4u o; o.x = pk2(s[0 * 33], s[1 * 33]); o.y = pk2(s[2 * 33], s[3 * 33]); o.z = pk2(s[4 * 33], s[5 * 33]); o.w = pk2(s[6 * 33], s[7 * 33]);
        const int nn = n0 + n; const int drow = row_off + (nn >> 7) * blk + (nn & 127);
        *(v4u*)(WT + (size_t)drow * K + k0 + 8 * c) = o; }
    LDS_WAIT();
}
__device__ __forceinline__ void prologue(const Args& a, LAS unsigned char* lds, bf16* HB, int gw, int NGW, int wave, int lane) {
    LAS float* scr = (LAS float*)(lds + wave * 16384);
    constexpr int I_G = (DM / 64) * (DFF / 32), I_D = (DFF / 64) * (DM / 32), I_IN = (DM / 64) * (DIN / 32), I_OUT = (DM / 64) * (DM / 32);
    constexpr int I_LAYER = 4 * I_G + 2 * I_D + I_IN + I_OUT;
    bf16* Wb = (bf16*)(a.ws + WS_W);
    for (int it = gw; it < I_LAYER * DEPTH; it += NGW) {
        const int l = it / I_LAYER; int r = it % I_LAYER; bf16* Wl = Wb + (size_t)l * W_LAYER;
        if (r < I_G) { transpose_item(a.in[2] + (size_t)l * DM * DFF, DM, DFF, Wl + OFF_GU1, 256, 0, scr, r, lane); continue; } r -= I_G;
        if (r < I_G) { transpose_item(a.in[3] + (size_t)l * DM * DFF, DM, DFF, Wl + OFF_GU1, 256, 128, scr, r, lane); continue; } r -= I_G;
        if (r < I_D) { transpose_item(a.in[4] + (size_t)l * DM * DFF, DFF, DM, Wl + OFF_D1, 128, 0, scr, r, lane); continue; } r -= I_D;
        if (r < I_IN) { transpose_item(a.in[7] + (size_t)l * DM * DIN, DM, DIN, Wl + OFF_IN, 128, 0, scr, r, lane); continue; } r -= I_IN;
        if (r < I_OUT) { transpose_item(a.in[18] + (size_t)l * DM * DM, DM, DM, Wl + OFF_OUT, 128, 0, scr, r, lane); continue; } r -= I_OUT;
        if (r < I_G) { transpose_item(a.in[21] + (size_t)l * DM * DFF, DM, DFF, Wl + OFF_GU2, 256, 0, scr, r, lane); continue; } r -= I_G;
        if (r < I_G) { transpose_item(a.in[22] + (size_t)l * DM * DFF, DM, DFF, Wl + OFF_GU2, 256, 128, scr, r, lane); continue; } r -= I_G;
        transpose_item(a.in[23] + (size_t)l * DM * DFF, DFF, DM, Wl + OFF_D2, 128, 0, scr, r, lane);
    }
    float* HF = (float*)(a.ws + WS_HF);
    for (int r = gw; r < MT; r += NGW) {
        const int b = r / LTOK, t = r % LTOK;
        const float* src = t < NMETA ? a.in[1] + (size_t)t * DM : a.in[0] + ((size_t)b * SEQ + (t - NMETA)) * DM;
        const f32x4* s4 = (const f32x4*)src + lane; f32x4* d4 = (f32x4*)(HF + (size_t)r * DM) + lane; v2u* b2 = (v2u*)(HB + (size_t)r * DM) + lane;
#pragma unroll
        for (int j = 0; j < 4; ++j) { const f32x4 v = s4[64 * j]; d4[64 * j] = v; v2u o; o.x = pk2(v.x, v.y); o.y = pk2(v.z, v.w); b2[64 * j] = o; }
    }
    float* rope = (float*)(a.ws + WS_ROPE);
    for (int i = gw * 64 + lane; i < LTOK * 8; i += NGW * 64) {
        const int pos = i >> 3, f = i & 7;
        const float inv = __builtin_amdgcn_exp2f(-(float)f * (18.931568569324174f / 8.0f));
        const float ang = (float)pos * inv;
        const double rev = (double)ang * 0.15915494309189535; const float fr = (float)(rev - rint(rev));
        rope[pos * 16 + f] = __builtin_amdgcn_cosf(fr); rope[pos * 16 + 8 + f] = __builtin_amdgcn_sinf(fr);
    }
}

__device__ __forceinline__ void ln_rows(const float* gam, const float* bet, float* HF, bf16* HB, float* out, bool fin, int gw, int NGW, int lane) {
    f32x4 g4[4], b4[4];
#pragma unroll
    for (int j = 0; j < 4; ++j) { g4[j] = ((const f32x4*)gam)[lane + 64 * j]; b4[j] = ((const f32x4*)bet)[lane + 64 * j]; }
    for (int r = gw; r < MT; r += NGW) {
        f32x4* p = (f32x4*)(HF + (size_t)r * DM) + lane;
        f32x4 v[4]; float s = 0.f;
#pragma unroll
        for (int j = 0; j < 4; ++j) { v[j] = p[64 * j]; s += (v[j].x + v[j].y) + (v[j].z + v[j].w); }
        const float mean = wave_sum(s) * (1.f / DM); float s2 = 0.f;
#pragma unroll
        for (int j = 0; j < 4; ++j) { v[j] = v[j] - mean; s2 += (v[j].x * v[j].x + v[j].y * v[j].y) + (v[j].z * v[j].z + v[j].w * v[j].w); }
        const float rstd = 1.f / sqrtf(wave_sum(s2) * (1.f / DM) + LN_EPS);
        if (!fin) {
            v2u* b2 = (v2u*)(HB + (size_t)r * DM) + lane;
#pragma unroll
            for (int j = 0; j < 4; ++j) { const f32x4 o = v[j] * rstd * g4[j] + b4[j]; p[64 * j] = o; v2u w; w.x = pk2(o.x, o.y); w.y = pk2(o.z, o.w); b2[64 * j] = w; }
        } else {
            const int b = r / LTOK, t = r % LTOK;
            if (t >= NMETA) { f32x4* o4 = (f32x4*)(out + ((size_t)b * SEQ + (t - NMETA)) * DM) + lane;
#pragma unroll
                for (int j = 0; j < 4; ++j) o4[64 * j] = v[j] * rstd * g4[j] + b4[j]; }
        }
    }
}

__device__ __forceinline__ float gelu_tanh(float x) {
    const float u = 0.7978845608028654f * (x + 0.044715f * x * x * x);
    return x * __builtin_amdgcn_rcpf(1.0f + __builtin_amdgcn_exp2f(-2.0f * 1.4426950408889634f * u));
}
__device__ __forceinline__ float sigmoid_f(float x) { return __builtin_amdgcn_rcpf(1.0f + __builtin_amdgcn_exp2f(-1.4426950408889634f * x)); }
constexpr int REC_CH = 128, REC_NCH = (LTOK + REC_CH - 1) / REC_CH;
constexpr int SJ = 145;
__device__ __forceinline__ void rec_unit(LAS unsigned char* lds, const Args& a, int l, int b, int hb, int jh, const bf16* proj, bf16* ymix, float* stats, int tid, int wave, int lane) {
    LAS bf16* XC = (LAS bf16*)lds;
    LAS float* RA = (LAS float*)(lds + 18432);
    LAS float* IX = RA + 32 * SJ;
    LAS float* XF = IX + 32 * SJ;
    LAS float* HT = XF + 32 * SJ;
    const float* conv_w = a.in[8] + (size_t)l * 4 * 512; const float* conv_b = a.in[9] + (size_t)l * 512;
    const float* ga_w = a.in[10] + ((size_t)l * 8 + hb) * 4096; const float* ga_b = a.in[11] + (size_t)l * 512;
    const float* gx_w = a.in[12] + ((size_t)l * 8 + hb) * 4096; const float* gx_b = a.in[13] + (size_t)l * 512;
    const float* lam = a.in[14] + (size_t)l * 512; const float* g_rec = a.in[16] + (size_t)l * 512;
    const int hi = lane >> 5, l31 = lane & 31;
    const int seg = tid & 7, c0 = hb * 64 + seg * 8;
    float cw[4][8], cb[8];
#pragma unroll
    for (int e = 0; e < 8; ++e) { cb[e] = conv_b[c0 + e];
#pragma unroll
        for (int k = 0; k < 4; ++k) cw[k][e] = conv_w[k * 512 + c0 + e]; }
    const int rt = wave >> 1, gt = wave & 1;
    const float* gw_ = gt ? gx_w : ga_w;
    bf16x8 bfr[4];
#pragma unroll
    for (int ks = 0; ks < 4; ++ks) { unsigned w[4];
#pragma unroll
        for (int e = 0; e < 4; ++e) { const int k = 16 * ks + 8 * hi + 2 * e; w[e] = pk2(gw_[k * 64 + jh * 32 + l31], gw_[(k + 1) * 64 + jh * 32 + l31]); }
        v4u t; t.x = w[0]; t.y = w[1]; t.z = w[2]; t.w = w[3]; bfr[ks] = __builtin_bit_cast(bf16x8, t); }
    const float gbias = (gt ? gx_b : ga_b)[hb * 64 + jh * 32 + l31];
    const int sj = 4 * wave + (lane >> 4), ss_ = lane & 15, sc = hb * 64 + jh * 32 + sj;
    float cj;
    { const float x = __expf(-lam[sc]);
      const float sp = x < 0.05f ? x * (1.0f + x * (-0.5f + x * ((1.0f / 3.0f) + x * (-0.25f + x * 0.2f)))) : __logf(1.0f + x);
      cj = -8.0f * sp; }
    float hprev = 0.f;
    const int wt = tid >> 2, wq = tid & 3, wc0 = hb * 64 + jh * 32 + wq * 8;
    float gr[8];
#pragma unroll
    for (int e = 0; e < 8; ++e) gr[e] = g_rec[wc0 + e];

    for (int ch = 0; ch < REC_NCH; ++ch) {
        const int t0 = ch * REC_CH;
        v4u gatev = (v4u){0u, 0u, 0u, 0u};
        if (t0 + wt < LTOK) gatev = *(const v4u*)(proj + (size_t)row_of(b, t0 + wt) * DIN + 512 + wc0);
#pragma unroll
        for (int it = 0; it < 2; ++it) {
            const int tt = (tid >> 3) + 64 * it, t = t0 + tt;
            float o[8];
#pragma unroll
            for (int e = 0; e < 8; ++e) o[e] = cb[e];
            if (t < LTOK) {
#pragma unroll
                for (int k = 0; k < 4; ++k) { const int ts = t - 3 + k;
                    if (ts >= 0) { const v4u x = *(const v4u*)(proj + (size_t)row_of(b, ts) * DIN + c0);
                        o[0] += cw[k][0] * bflo(x.x); o[1] += cw[k][1] * bfhi(x.x); o[2] += cw[k][2] * bflo(x.y); o[3] += cw[k][3] * bfhi(x.y);
                        o[4] += cw[k][4] * bflo(x.z); o[5] += cw[k][5] * bfhi(x.z); o[6] += cw[k][6] * bflo(x.w); o[7] += cw[k][7] * bfhi(x.w); } }
            } else {
#pragma unroll
                for (int e = 0; e < 8; ++e) o[e] = 0.f;
            }
            v4u w; w.x = pk2(o[0], o[1]); w.y = pk2(o[2], o[3]); w.z = pk2(o[4], o[5]); w.w = pk2(o[6], o[7]);
            *(LAS v4u*)(XC + tt * 72 + seg * 8) = w;
            if ((seg >> 2) == jh) {
#pragma unroll
                for (int e = 0; e < 8; ++e) XF[((seg & 3) * 8 + e) * SJ + (tt >> 3) * 9 + (tt & 7)] = o[e];
            }
        }
        __syncthreads();
        {
            f32x16 acc;
#pragma unroll
            for (int i = 0; i < 16; ++i) acc[i] = 0.f;
#pragma unroll
            for (int ks = 0; ks < 4; ++ks) { const bf16x8 af = *(const LAS bf16x8*)(XC + (32 * rt + l31) * 72 + 16 * ks + 8 * hi);
                acc = __builtin_amdgcn_mfma_f32_32x32x16_bf16(af, bfr[ks], acc, 0, 0, 0); }
            LAS float* G = gt ? IX : RA;
#pragma unroll
            for (int i = 0; i < 16; ++i) { const int tt = 32 * rt + crow(i, hi); G[l31 * SJ + (tt >> 3) * 9 + (tt & 7)] = sigmoid_f(acc[i] + gbias); }
        }
        __syncthreads();
        {
            float av[8], gv[8]; float A = 1.f, H = 0.f;
            const int base = sj * SJ + ss_ * 9;
#pragma unroll
            for (int i = 0; i < 8; ++i) {
                const float ra = RA[base + i], ix = IX[base + i], xf = XF[base + i];
                const float la = cj * ra; const float ai = __expf(la);
                const float x2 = 2.0f * la;
                const float em = (x2 > -0.02f) ? -x2 * (1.0f + x2 * (0.5f + x2 * (1.0f / 6.0f))) : 1.0f - ai * ai;
                const float gi = sqrtf(em) * (ix * xf);
                av[i] = ai; gv[i] = gi; A *= ai; H = ai * H + gi;
            }
#pragma unroll
            for (int d = 1; d < 16; d <<= 1) { const float Ao = __shfl_up(A, d, 16), Ho = __shfl_up(H, d, 16); if (ss_ >= d) { H = A * Ho + H; A = A * Ao; } }
            float Ae = __shfl_up(A, 1, 16), He = __shfl_up(H, 1, 16); if (ss_ == 0) { Ae = 1.f; He = 0.f; }
            float h = Ae * hprev + He;
            const float Al = __shfl(A, 15, 16), Hl = __shfl(H, 15, 16);
            hprev = Al * hprev + Hl;
#pragma unroll
            for (int i = 0; i < 8; ++i) { h = av[i] * h + gv[i]; HT[(ss_ * 8 + i) * 33 + sj] = h; }
        }
        __syncthreads();
        {
            const int t = t0 + wt;
            float y[8]; float s2 = 0.f;
            const float gf[8] = {bflo(gatev.x), bfhi(gatev.x), bflo(gatev.y), bfhi(gatev.y), bflo(gatev.z), bfhi(gatev.z), bflo(gatev.w), bfhi(gatev.w)};
#pragma unroll
            for (int e = 0; e < 8; ++e) { y[e] = HT[wt * 33 + wq * 8 + e] * gelu_tanh(gf[e]); s2 += y[e] * y[e]; }
            s2 += __shfl_xor(s2, 1); s2 += __shfl_xor(s2, 2);
            if (t < LTOK) {
                const int r = row_of(b, t);
                v4u w; w.x = pk2(y[0] * gr[0], y[1] * gr[1]); w.y = pk2(y[2] * gr[2], y[3] * gr[3]); w.z = pk2(y[4] * gr[4], y[5] * gr[5]); w.w = pk2(y[6] * gr[6], y[7] * gr[7]);
                *(v4u*)(ymix + (size_t)r * DM + wc0) = w;
                if (wq == 0) __hip_atomic_fetch_add(stats + 2 * (size_t)r, s2, __ATOMIC_RELAXED, __HIP_MEMORY_SCOPE_AGENT);
            }
        }
    }
    __syncthreads();
}

constexpr int KS_STR = 72, VT_STR = 296, PS_STR = 40;
constexpr int ATT_KS = 0, ATT_VT = 288 * KS_STR * 2, ATT_PS = ATT_VT + 64 * VT_STR * 2;
__device__ __forceinline__ void attn_unit(LAS unsigned char* lds, const Args& a, int l, int b, int j, int g, const bf16* proj, bf16* ymix, float* stats, const float* rope, int tid, int wave, int lane) {
    LAS bf16* KS = (LAS bf16*)(lds + ATT_KS);
    LAS bf16* VT = (LAS bf16*)(lds + ATT_VT);
    LAS bf16* PS = (LAS bf16*)(lds + ATT_PS + wave * (32 * PS_STR * 2));
    const float* sinks = a.in[15] + l * 8; const float* g_attn = a.in[17] + (size_t)l * 512;
    const int hi = lane >> 5, l31 = lane & 31;
    const int kbase = NMETA + 128 * (j - 1);
    for (int it = tid; it < 288 * 4; it += NWAVES * 64) {
        const int kr = it >> 2, sg = it & 3;
        const int pos = kr < 32 ? kr : kbase + (kr - 32);
        const bool valid = (kr < NMETA) || (kr >= 32 && pos >= NMETA);
        v4u w0 = (v4u){0u, 0u, 0u, 0u}, w1 = w0;
        if (valid) {
            const bf16* src = proj + (size_t)row_of(b, pos) * DIN + 1536 + g * 64 + sg * 16;
            w0 = *(const v4u*)src; w1 = *(const v4u*)(src + 8);
            if (sg == 0) {
                const f32x4 c0 = *(const f32x4*)(rope + pos * 16), c1 = *(const f32x4*)(rope + pos * 16 + 4), s0 = *(const f32x4*)(rope + pos * 16 + 8), s1 = *(const f32x4*)(rope + pos * 16 + 12);
                const float x1[8] = {bflo(w0.x), bfhi(w0.x), bflo(w0.y), bfhi(w0.y), bflo(w0.z), bfhi(w0.z), bflo(w0.w), bfhi(w0.w)};
                const float x2[8] = {bflo(w1.x), bfhi(w1.x), bflo(w1.y), bfhi(w1.y), bflo(w1.z), bfhi(w1.z), bflo(w1.w), bfhi(w1.w)};
                const float cc[8] = {c0.x, c0.y, c0.z, c0.w, c1.x, c1.y, c1.z, c1.w}, sn[8] = {s0.x, s0.y, s0.z, s0.w, s1.x, s1.y, s1.z, s1.w};
                float o1[8], o2[8];
#pragma unroll
                for (int e = 0; e < 8; ++e) { o1[e] = x1[e] * cc[e] - x2[e] * sn[e]; o2[e] = x2[e] * cc[e] + x1[e] * sn[e]; }
                w0.x = pk2(o1[0], o1[1]); w0.y = pk2(o1[2], o1[3]); w0.z = pk2(o1[4], o1[5]); w0.w = pk2(o1[6], o1[7]);
                w1.x = pk2(o2[0], o2[1]); w1.y = pk2(o2[2], o2[3]); w1.z = pk2(o2[4], o2[5]); w1.w = pk2(o2[6], o2[7]);
            }
        }
        *(LAS v4u*)(KS + kr * KS_STR + sg * 16) = w0; *(LAS v4u*)(KS + kr * KS_STR + sg * 16 + 8) = w1;
    }
    for (int it = tid; it < 288 * 8; it += NWAVES * 64) {
        const int kr = it % 288, sg = it / 288;
        const int pos = kr < 32 ? kr : kbase + (kr - 32);
        const bool valid = (kr < NMETA) || (kr >= 32 && pos >= NMETA);
        v4u w = (v4u){0u, 0u, 0u, 0u};
        if (valid) w = *(const v4u*)(proj + (size_t)row_of(b, pos) * DIN + 1664 + g * 64 + sg * 8);
        LAS bf16* d = VT + (sg * 8) * VT_STR + kr;
        d[0 * VT_STR] = (bf16)(w.x & 0xffff); d[1 * VT_STR] = (bf16)(w.x >> 16); d[2 * VT_STR] = (bf16)(w.y & 0xffff); d[3 * VT_STR] = (bf16)(w.y >> 16);
        d[4 * VT_STR] = (bf16)(w.z & 0xffff); d[5 * VT_STR] = (bf16)(w.z >> 16); d[6 * VT_STR] = (bf16)(w.w & 0xffff); d[7 * VT_STR] = (bf16)(w.w >> 16);
    }
    __syncthreads();
    const int NT = 4 * (j == 0 ? 5 : 4);
    for (int wtile = wave; wtile < NT; wtile += NWAVES) {
        const int hq = wtile & 3, qt = wtile >> 2, h = 4 * g + hq;
        const int tq0 = qt < 4 ? NMETA + 128 * j + 32 * qt : 0;
        const int btb = qt < 4 ? qt : 0;
        const float sink = sinks[h];
        bf16x8 qf[4];
        {
            const int tq = tq0 + l31;
            const bf16* src = proj + (size_t)row_of(b, tq) * DIN + 1024 + h * 64;
            const v4u wa = *(const v4u*)src, wb = *(const v4u*)(src + 8);
            const f32x4 c0 = *(const f32x4*)(rope + tq * 16), c1 = *(const f32x4*)(rope + tq * 16 + 4), s0 = *(const f32x4*)(rope + tq * 16 + 8), s1 = *(const f32x4*)(rope + tq * 16 + 12);
            const float x1[8] = {bflo(wa.x), bfhi(wa.x), bflo(wa.y), bfhi(wa.y), bflo(wa.z), bfhi(wa.z), bflo(wa.w), bfhi(wa.w)};
            const float x2[8] = {bflo(wb.x), bfhi(wb.x), bflo(wb.y), bfhi(wb.y), bflo(wb.z), bfhi(wb.z), bflo(wb.w), bfhi(wb.w)};
            const float cc[8] = {c0.x, c0.y, c0.z, c0.w, c1.x, c1.y, c1.z, c1.w}, sn[8] = {s0.x, s0.y, s0.z, s0.w, s1.x, s1.y, s1.z, s1.w};
            float o[8];
#pragma unroll
            for (int e = 0; e < 8; ++e) o[e] = 0.125f * (hi == 0 ? x1[e] * cc[e] - x2[e] * sn[e] : x2[e] * cc[e] + x1[e] * sn[e]);
            v4u t; t.x = pk2(o[0], o[1]); t.y = pk2(o[2], o[3]); t.z = pk2(o[4], o[5]); t.w = pk2(o[6], o[7]); qf[0] = __builtin_bit_cast(bf16x8, t);
#pragma unroll
            for (int ks = 1; ks < 4; ++ks) { const v4u w = *(const v4u*)(src + 16 * ks + 8 * hi);
                v4u u; u.x = pk2(0.125f * bflo(w.x), 0.125f * bfhi(w.x)); u.y = pk2(0.125f * bflo(w.y), 0.125f * bfhi(w.y)); u.z = pk2(0.125f * bflo(w.z), 0.125f * bfhi(w.z)); u.w = pk2(0.125f * bflo(w.w), 0.125f * bfhi(w.w));
                qf[ks] = __builtin_bit_cast(bf16x8, u); }
        }
        f32x16 S[6];
#pragma unroll
        for (int kt = 0; kt < 6; ++kt) {
            const int kr0 = kt == 0 ? 0 : 32 + 32 * (btb + kt - 1);
            f32x16 acc;
#pragma unroll
            for (int i = 0; i < 16; ++i) acc[i] = 0.f;
#pragma unroll
            for (int ks = 0; ks < 4; ++ks) { const bf16x8 kf = *(const LAS bf16x8*)(KS + (kr0 + l31) * KS_STR + 16 * ks + 8 * hi);
                acc = __builtin_amdgcn_mfma_f32_32x32x16_bf16(qf[ks], kf, acc, 0, 0, 0); }
            const int tk = kt == 0 ? l31 : kbase + 32 * (btb + kt - 1) + l31;
#pragma unroll
            for (int i = 0; i < 16; ++i) { const int tq = tq0 + crow(i, hi);
                const bool ok = kt == 0 ? (l31 < NMETA && tk <= tq) : (tk >= NMETA && tk <= tq && tq - tk < 128);
                acc[i] = ok ? acc[i] : -1e30f; }
            S[kt] = acc;
        }
        float inv[16];
#pragma unroll
        for (int i = 0; i < 16; ++i) {
            float m = S[0][i];
#pragma unroll
            for (int kt = 1; kt < 6; ++kt) m = fmaxf(m, S[kt][i]);
#pragma unroll
            for (int o = 1; o < 32; o <<= 1) m = fmaxf(m, __shfl_xor(m, o));
            m = fmaxf(m, sink);
            float s = 0.f;
#pragma unroll
            for (int kt = 0; kt < 6; ++kt) { const float p = __expf(S[kt][i] - m); S[kt][i] = p; s += p; }
#pragma unroll
            for (int o = 1; o < 32; o <<= 1) s += __shfl_xor(s, o);
            inv[i] = 1.0f / (s + __expf(sink - m));
        }
        f32x16 O0, O1;
#pragma unroll
        for (int i = 0; i < 16; ++i) { O0[i] = 0.f; O1[i] = 0.f; }
#pragma unroll
        for (int kt = 0; kt < 6; ++kt) {
            const int kr0 = kt == 0 ? 0 : 32 + 32 * (btb + kt - 1);
#pragma unroll
            for (int i = 0; i < 16; ++i) PS[crow(i, hi) * PS_STR + l31] = (bf16)(pk2(S[kt][i] * inv[i], 0.f) & 0xffff);
            LDS_WAIT();
#pragma unroll
            for (int k2 = 0; k2 < 2; ++k2) {
                const bf16x8 pf = *(const LAS bf16x8*)(PS + l31 * PS_STR + 16 * k2 + 8 * hi);
                const bf16x8 v0 = *(const LAS bf16x8*)(VT + l31 * VT_STR + kr0 + 16 * k2 + 8 * hi);
                const bf16x8 v1 = *(const LAS bf16x8*)(VT + (32 + l31) * VT_STR + kr0 + 16 * k2 + 8 * hi);
                O0 = __builtin_amdgcn_mfma_f32_32x32x16_bf16(pf, v0, O0, 0, 0, 0);
                O1 = __builtin_amdgcn_mfma_f32_32x32x16_bf16(pf, v1, O1, 0, 0, 0);
            }
            LDS_WAIT();
        }
        const float ga0 = g_attn[h * 64 + l31], ga1 = g_attn[h * 64 + 32 + l31];
#pragma unroll
        for (int i = 0; i < 16; ++i) {
            const int tq = tq0 + crow(i, hi);
            float s2 = O0[i] * O0[i] + O1[i] * O1[i];
#pragma unroll
            for (int o = 1; o < 32; o <<= 1) s2 += __shfl_xor(s2, o);
            const bool ok = qt < 4 || tq < NMETA;
            if (ok) {
                const int r = row_of(b, tq);
                bf16* dst = ymix + (size_t)r * DM + 512 + h * 64;
                dst[l31] = (bf16)(pk2(O0[i] * ga0, 0.f) & 0xffff); dst[32 + l31] = (bf16)(pk2(O1[i] * ga1, 0.f) & 0xffff);
                if (l31 == 0) __hip_atomic_fetch_add(stats + 2 * (size_t)r + 1, s2, __ATOMIC_RELAXED, __HIP_MEMORY_SCOPE_AGENT);
            }
        }
    }
    __syncthreads();
}

#define RLX_AGENT __ATOMIC_RELAXED, __HIP_MEMORY_SCOPE_AGENT
#define XB_TMO      128
#define XB_XCNT(j)  (256  + 64 * (j))
#define XB_XSUB(j)  (1280 + 64 * (j))
#define XB_XGEN(j)  (2304 + 64 * (j))
#define XB_TOP      3328
#define XB_TOPGEN   3392
#define XCD_BAR_WORDS 3456
#define XB_SPIN_CAP (1u << 18)

__device__ __forceinline__ unsigned xb_ld(unsigned* p)              { return __hip_atomic_load(p, __ATOMIC_RELAXED, __HIP_MEMORY_SCOPE_AGENT); }
__device__ __forceinline__ unsigned xb_add(unsigned* p, unsigned v) { return __hip_atomic_fetch_add(p, v, __ATOMIC_RELAXED, __HIP_MEMORY_SCOPE_AGENT); }
__device__ __forceinline__ unsigned xb_xcc_id() { return (unsigned)__builtin_amdgcn_s_getreg((3 << 11) | 20) & 0xFu; }
#define XB_SPIN(cond, bar) do { unsigned _sp = 0; while (cond) { __builtin_amdgcn_s_sleep(1); \
    if ((++_sp & 255u) == 0u) { if (xb_ld(&(bar)[XB_TMO])) break; if (_sp > XB_SPIN_CAP) { atomicAdd(&(bar)[XB_TMO], 1u); break; } } } } while (0)

struct XcdBarrier {
    unsigned* bar; unsigned x;
    volatile LAS unsigned* st;
};

__device__ __forceinline__ XcdBarrier xcd_barrier_post(unsigned* bar, volatile LAS unsigned* st) {
    XcdBarrier b; b.bar = bar; b.x = xb_xcc_id(); b.st = st;
    if (threadIdx.x == 0) (void)xb_add(&bar[XB_XCNT(b.x)], 1u);
    return b;
}
__device__ __forceinline__ void xcd_barrier_complete(unsigned* bar, unsigned x, unsigned& nloc, unsigned& nx) {
    const unsigned G = gridDim.x * gridDim.y * gridDim.z;
    unsigned sum, cnt, mine, sp = 0u;
    for (;;) {
        sum = 0u; cnt = 0u; mine = 0u;
#pragma unroll
        for (unsigned j = 0; j < 16; ++j) { const unsigned c = xb_ld(&bar[XB_XCNT(j)]); sum += c; cnt += (c > 0u) ? 1u : 0u; mine = (j == x) ? c : mine; }
        if (sum == G) break;
        __builtin_amdgcn_s_sleep(1);
        if ((++sp & 255u) == 0u) { if (xb_ld(&bar[XB_TMO])) break; if (sp > XB_SPIN_CAP) { atomicAdd(&bar[XB_TMO], 1u); break; } }
    }
    nloc = mine > 0u ? mine : 1u; nx = cnt > 0u ? cnt : 1u;
}

__device__ __forceinline__ void xcd_barrier(const XcdBarrier& b) {
    asm volatile("s_waitcnt vmcnt(0)" ::: "memory");
    __syncthreads();
    if (threadIdx.x == 0) {
        unsigned* bar = b.bar;
        __builtin_amdgcn_s_waitcnt(0);
        unsigned nloc = b.st[0], nx = b.st[1];
        if (nloc == 0u) { xcd_barrier_complete(bar, b.x, nloc, nx); b.st[0] = nloc; b.st[1] = nx; }
        const unsigned old = xb_add(&bar[XB_XSUB(b.x)], 1u);
        const unsigned gen = old / nloc;
        if (old + 1u == (gen + 1u) * nloc) {
            __builtin_amdgcn_fence(__ATOMIC_RELEASE, "agent");
            asm volatile("s_waitcnt vmcnt(0)" ::: "memory");
            const unsigned og = xb_add(&bar[XB_TOP], 1u);
            const unsigned tg = og / nx;
            if (og + 1u == (tg + 1u) * nx) xb_add(&bar[XB_TOPGEN], 1u);
            else XB_SPIN(xb_ld(&bar[XB_TOPGEN]) == tg, bar);
            __builtin_amdgcn_fence(__ATOMIC_ACQUIRE, "agent");
            xb_add(&bar[XB_XGEN(b.x)], 1u);
            asm volatile("s_waitcnt vmcnt(0)" ::: "memory");
        } else {
            XB_SPIN(xb_ld(&bar[XB_XGEN(b.x)]) == gen, bar);
            __builtin_amdgcn_fence(__ATOMIC_ACQUIRE, "agent");
            asm volatile("s_waitcnt vmcnt(0)" ::: "memory");
        }
    }
    __syncthreads();
}

constexpr size_t WS_BAR = 16384;
constexpr int MISC_OFF = 131072 + 320;
constexpr int N_PHASES = 1 + 10 * DEPTH;
__global__ void __launch_bounds__(NWAVES * 64, 2) fwd_kernel(Args args) {
    extern __shared__ __attribute__((aligned(16))) unsigned char lds_raw[];
    LAS unsigned char* lds = (LAS unsigned char*)lds_raw;
    cg::grid_group grid = cg::this_grid();
    volatile LAS unsigned* MISC = (volatile LAS unsigned*)(lds + MISC_OFF);
    if (threadIdx.x < 32) MISC[threadIdx.x] = 0u;
    __syncthreads();
    XcdBarrier bar = xcd_barrier_post((unsigned*)(args.ws + WS_BAR), MISC + 8);
    const int G = gridDim.x, bx = blockIdx.x;
    const int vcu = (G % 8 == 0) ? (bx % 8) * (G / 8) + bx / 8 : bx;
    const int NGW = G * NWAVES;
    unsigned char* ws = args.ws;
    float* HF = (float*)(ws + WS_HF);
    bf16* HB = (bf16*)args.out;
    bf16* ACT = (bf16*)(ws + WS_ACT); bf16* PROJ = (bf16*)(ws + WS_PROJ); bf16* YMIX = (bf16*)(ws + WS_YMIX);
    const float* rope = (const float*)(ws + WS_ROPE);

    for (int p = args.ph_lo; p < args.ph_hi; ++p) {
        int tid_ = threadIdx.x; asm volatile("" : "+v"(tid_));
        const int tid = tid_, lane = tid & 63, wave = __builtin_amdgcn_readfirstlane(tid >> 6), gw = vcu * NWAVES + wave;
        if (p == 0) {
            prologue(args, lds, HB, gw, NGW, wave, lane);
        } else {
            const int l = (p - 1) / 10, s = (p - 1) % 10;
            const bf16* Wl = (const bf16*)(ws + WS_W) + (size_t)l * W_LAYER;
            float* stats = (float*)(ws + WS_STATS) + (size_t)l * MT * 2;
            if (s == 0 || s == 7) {
                pg8::Gemm g{HB, Wl + (s == 0 ? OFF_GU1 : OFF_GU2), MT, 2 * DFF, DM}; pg8::StaticOrder S; S.init(MT, 2 * DFF, G, bx);
                pg8::EpiSwiGLU E{ACT, DFF};
                pg8::gemm_phase<pg8::EpiSwiGLU, pg8::StaticOrder, true, true>(lds, g, S, E);
            } else if (s == 1 || s == 8) {
                pg8::Gemm g{ACT, Wl + (s == 1 ? OFF_D1 : OFF_D2), MT, DM, DFF}; pg8::StaticOrder S; S.init(MT, DM, G, bx);
                pg8::EpiRes<false> E{HF, DM, DN_ALPHA, 0.5f, nullptr};
                pg8::gemm_phase<pg8::EpiRes<false>, pg8::StaticOrder, true, true>(lds, g, S, E);
            } else if (s == 2 || s == 6 || s == 9) {
                const int gi = s == 2 ? 5 : (s == 6 ? 19 : 24);
                ln_rows(args.in[gi] + (size_t)l * DM, args.in[gi + 1] + (size_t)l * DM, HF, HB, args.out, (l == DEPTH - 1 && s == 9), gw, NGW, lane);
            } else if (s == 3) {
                pg8::Gemm g{HB, Wl + OFF_IN, MT, DIN, DM}; pg8::StaticOrder S; S.init(MT, DIN, G, bx);
                pg8::EpiStore E{PROJ, DIN};
                pg8::gemm_phase<pg8::EpiStore, pg8::StaticOrder, true, true>(lds, g, S, E);
            } else if (s == 4) {
                for (int u = bx; u < 256 + 512; u += G) {
                    if (u < 256) rec_unit(lds, args, l, u >> 4, (u >> 1) & 7, u & 1, PROJ, YMIX, stats, tid, wave, lane);
                    else { const int v = u - 256; attn_unit(lds, args, l, v >> 5, (v >> 1) & 15, v & 1, PROJ, YMIX, stats, rope, tid, wave, lane); }
                }
            } else {
                pg8::Gemm g{YMIX, Wl + OFF_OUT, MT, DM, DM}; pg8::StaticOrder S; S.init(MT, DM, G, bx);
                pg8::EpiRes<true> E{HF, DM, DN_ALPHA, 1.0f, stats};
                pg8::gemm_phase<pg8::EpiRes<true>, pg8::StaticOrder, true, true>(lds, g, S, E);
            }
        }
        if (p + 1 < args.ph_hi) { if (p == 0) grid.sync(); else xcd_barrier(bar); }
    }
}

extern "C" void kernel_launch(void* const* d_in, const int* in_sizes, int n_in, void* d_out, int out_size, void* d_ws, size_t ws_size, hipStream_t stream) {
    static int grid = 0;
    if (grid == 0) {
        if (n_in != 26 || ws_size < WS_END || (size_t)out_size * 4 < (size_t)MT * DM * 2) { fprintf(stderr, "kernel_launch: unexpected sizes n_in %d ws %zu out %d\n", n_in, ws_size, out_size); grid = -1; return; }
        int dev = 0, cus = 0, per_cu = 0;
        hipGetDevice(&dev); hipDeviceGetAttribute(&cus, hipDeviceAttributeMultiprocessorCount, dev);
        if (hipFuncSetAttribute((const void*)fwd_kernel, hipFuncAttributeMaxDynamicSharedMemorySize, LDS_BYTES) != hipSuccess) { fprintf(stderr, "kernel_launch: hipFuncSetAttribute failed\n"); grid = -1; return; }
        if (hipOccupancyMaxActiveBlocksPerMultiprocessor(&per_cu, (const void*)fwd_kernel, NWAVES * 64, LDS_BYTES) != hipSuccess || per_cu < 1) { fprintf(stderr, "kernel_launch: occupancy query says %d\n", per_cu); per_cu = 1; }
        (void)hipGetLastError();
        grid = cus * 1;
    }
    if (grid < 0) return;
    hipMemsetAsync((char*)d_ws + WS_CTL, 0, CTL_BYTES, stream);
    Args a{};
    for (int i = 0; i < 26; ++i) a.in[i] = (const float*)d_in[i];
    a.out = (float*)d_out; a.ws = (unsigned char*)d_ws;
#if MK_LAUNCH_PER_PHASE
    for (int p = 0; p < N_PHASES; ++p) {
        a.ph_lo = p; a.ph_hi = p + 1; void* kargs[] = {&a};
        hipError_t e = hipLaunchCooperativeKernel((const void*)fwd_kernel, dim3(grid), dim3(NWAVES * 64), kargs, LDS_BYTES, stream);
        if (e != hipSuccess) { fprintf(stderr, "launch %d failed: %s\n", p, hipGetErrorString(e)); break; }
    }
#else
    a.ph_lo = 0; a.ph_hi = N_PHASES; void* kargs[] = {&a};
    hipError_t e = hipLaunchCooperativeKernel((const void*)fwd_kernel, dim3(grid), dim3(NWAVES * 64), kargs, LDS_BYTES, stream);
    if (e != hipSuccess) fprintf(stderr, "cooperative launch failed: %s (grid %d)\n", hipGetErrorString(e), grid);
#endif
}
```
